# Optimizing an MI355X kernel written in HIP

```python
import math
import jax, jax.numpy as jnp
from jax import lax
import numpy as np

D_MODEL = 1024
BATCH = 8
SEQ = 4096
DEPTH = 2

CHUNK = 64
Q_BLOCK = 128
MEM_LEN = 256
ROPE_THETA = 10000.0
NORM_EPS = 1e-6

D_FF = 2816
DIFF_HEADS = 4
DIFF_HEAD_DIM = 64
DIFF_V_DIM = 2 * DIFF_HEAD_DIM
SB_HEADS = 8
SB_HEAD_DIM = 64
A_QK_WIDTH = 2 * DIFF_HEADS * DIFF_HEAD_DIM
A_V_WIDTH = DIFF_HEADS * DIFF_V_DIM
B_WIDTH = SB_HEADS * SB_HEAD_DIM
AB_SPLITS = (A_QK_WIDTH, 2 * A_QK_WIDTH, 2 * A_QK_WIDTH + A_V_WIDTH,
             2 * A_QK_WIDTH + A_V_WIDTH + B_WIDTH, 2 * A_QK_WIDTH + A_V_WIDTH + 2 * B_WIDTH)
AB_IN_WIDTH = 2 * A_QK_WIDTH + A_V_WIDTH + 3 * B_WIDTH
AB_MIX_WIDTH = A_V_WIDTH + B_WIDTH
MLA_HEADS = 16
MLA_Q_RANK = 512
MLA_KV_RANK = 256
MLA_NOPE_DIM = 64
MLA_ROPE_DIM = 32
MLA_V_DIM = 64
MLA_QK_DIM = MLA_NOPE_DIM + MLA_ROPE_DIM
XM_HEADS = 4
XM_HEAD_DIM = 128
XM_WIDTH = XM_HEADS * XM_HEAD_DIM

N_EVEN = (DEPTH + 1) // 2
N_ODD = DEPTH // 2

kernel_name = 'hybrid_diff_stickbreak_mla_macaron'


def rms_norm(x, gain):
    xf = x.astype(jnp.float32)
    y = xf * lax.rsqrt(jnp.mean(xf * xf, axis=-1, keepdims=True) + NORM_EPS)
    return (y * gain.astype(jnp.float32)).astype(x.dtype)


def rope(x):
    s, d = x.shape[-2], x.shape[-1]
    inv = 1.0 / (ROPE_THETA ** (jnp.arange(0, d, 2, dtype=jnp.float32) / d))
    ang = jnp.arange(s, dtype=jnp.float32)[:, None] * inv[None, :]
    cos, sin = jnp.cos(ang), jnp.sin(ang)
    xf = x.astype(jnp.float32)
    x1, x2 = xf[..., : d // 2], xf[..., d // 2:]
    return jnp.concatenate([x1 * cos - x2 * sin, x1 * sin + x2 * cos], axis=-1).astype(x.dtype)


def to_heads(t, n_heads):
    b, s, _ = t.shape
    return t.reshape(b, s, n_heads, -1).transpose(0, 2, 1, 3)


def from_heads(t):
    b, h, s, d = t.shape
    return t.transpose(0, 2, 1, 3).reshape(b, s, h * d)


def chunk_causal_mask(q_pos, k_pos):
    return (k_pos[None, :] // CHUNK) <= (q_pos[:, None] // CHUNK)


def sweep_query_blocks(block_fn, q):
    b, h, s, d = q.shape
    nb = s // Q_BLOCK
    qb = jnp.moveaxis(q.reshape(b, h, nb, Q_BLOCK, d), 2, 0)
    starts = jnp.arange(nb, dtype=jnp.int32) * Q_BLOCK
    out = lax.map(lambda a: block_fn(a[0], a[1]), (qb, starts))
    _, ob, oh, _, dv = out.shape
    return jnp.moveaxis(out, 0, 2).reshape(ob, oh, s, dv)


def chunk_causal_softmax_attention(q, k, v, scale):
    k_pos = jnp.arange(k.shape[2], dtype=jnp.int32)

    def block(qb, start):
        q_pos = start + jnp.arange(Q_BLOCK, dtype=jnp.int32)
        sc = jnp.einsum('bhqd,bhkd->bhqk', qb, k).astype(jnp.float32) * scale
        sc = jnp.where(chunk_causal_mask(q_pos, k_pos), sc, -jnp.inf)
        p = jax.nn.softmax(sc, axis=-1)
        return jnp.einsum('bhqk,bhkd->bhqd', p.astype(v.dtype), v)

    return sweep_query_blocks(block, q)


def differential_attention(q, k, v, lam, scale):
    n_h = v.shape[1]
    k_pos = jnp.arange(k.shape[2], dtype=jnp.int32)

    def block(qb, start):
        q_pos = start + jnp.arange(Q_BLOCK, dtype=jnp.int32)
        sc = jnp.einsum('bhqd,bhkd->bhqk', qb, k).astype(jnp.float32) * scale
        sc = jnp.where(chunk_causal_mask(q_pos, k_pos), sc, -jnp.inf)
        p = jax.nn.softmax(sc, axis=-1)
        p = p[:, :n_h] - lam * p[:, n_h:]
        return jnp.einsum('bhqk,bhkd->bhqd', p.astype(v.dtype), v)

    return sweep_query_blocks(block, q)


def stick_breaking_attention(q, k, v, scale):
    k_pos = jnp.arange(k.shape[2], dtype=jnp.int32)

    def block(qb, start):
        q_pos = start + jnp.arange(Q_BLOCK, dtype=jnp.int32)
        z = jnp.einsum('bhqd,bhkd->bhqk', qb, k).astype(jnp.float32) * scale
        strict = k_pos[None, :] < q_pos[:, None]
        log_beta = jax.nn.log_sigmoid(z)
        log_keep = jnp.where(strict, jax.nn.log_sigmoid(-z), 0.0)
        later = lax.cumsum(log_keep, axis=3, reverse=True) - log_keep
        w = jnp.where(strict, jnp.exp(log_beta + later), 0.0)
        return jnp.einsum('bhqk,bhkd->bhqd', w.astype(v.dtype), v)

    return sweep_query_blocks(block, q)


def swiglu(h, w_gate, w_up, w_down):
    return (jax.nn.silu(h @ w_gate) * (h @ w_up)) @ w_down


def diff_stickbreak_mixer(h, w_in, w_out, q_norm, k_norm, lq1, lk1, lq2, lk2, subln, lambda_init):
    proj = h @ w_in
    qa, ka, va, qb, kb, vb = jnp.split(proj, AB_SPLITS, axis=-1)
    qa = rope(rms_norm(to_heads(qa, 2 * DIFF_HEADS), q_norm))
    ka = rope(rms_norm(to_heads(ka, 2 * DIFF_HEADS), k_norm))
    va = to_heads(va, DIFF_HEADS)
    f32 = jnp.float32
    lam = (jnp.exp(jnp.sum(lq1.astype(f32) * lk1.astype(f32)))
           - jnp.exp(jnp.sum(lq2.astype(f32) * lk2.astype(f32))) + lambda_init)
    oa = differential_attention(qa, ka, va, lam, DIFF_HEAD_DIM ** -0.5)
    oa = rms_norm(oa, subln) * (1.0 - lambda_init)
    qb = to_heads(qb, SB_HEADS)
    kb = to_heads(kb, SB_HEADS)
    vb = to_heads(vb, SB_HEADS)
    ob = stick_breaking_attention(qb, kb, vb, SB_HEAD_DIM ** -0.5)
    mixed = jnp.concatenate([from_heads(oa), from_heads(ob)], axis=-1)
    return mixed @ w_out


def mla_mixer(h, w_dq, q_lat_norm, w_uq, w_dkv, kv_lat_norm, w_ukv, qk_norm_q, qk_norm_k, w_o):
    b, s, _ = h.shape
    c_q = rms_norm(h @ w_dq, q_lat_norm)
    q = to_heads(c_q @ w_uq, MLA_HEADS)
    dkv = h @ w_dkv
    c_kv = rms_norm(dkv[..., :MLA_KV_RANK], kv_lat_norm)
    k_rope = jnp.broadcast_to(dkv[:, None, :, MLA_KV_RANK:], (b, MLA_HEADS, s, MLA_ROPE_DIM))
    kv = to_heads(c_kv @ w_ukv, MLA_HEADS)
    k_nope, v = kv[..., :MLA_NOPE_DIM], kv[..., MLA_NOPE_DIM:]
    k = jnp.concatenate([k_nope, k_rope], axis=-1)
    q = rms_norm(q, qk_norm_q)
    k = rms_norm(k, qk_norm_k)
    q = jnp.concatenate([q[..., :MLA_NOPE_DIM], rope(q[..., MLA_NOPE_DIM:])], axis=-1)
    k = jnp.concatenate([k[..., :MLA_NOPE_DIM], rope(k[..., MLA_NOPE_DIM:])], axis=-1)
    o = chunk_causal_softmax_attention(q, k, v, MLA_QK_DIM ** -0.5)
    return from_heads(o) @ w_o


def memory_cross_attention(h, m, w_q, w_kv, q_norm, k_norm, w_o):
    q = rms_norm(to_heads(h @ w_q, XM_HEADS), q_norm)
    k, v = jnp.split(m @ w_kv, 2, axis=-1)
    k = rms_norm(to_heads(k, XM_HEADS), k_norm)
    v = to_heads(v, XM_HEADS)
    sc = jnp.einsum('bhqd,bhkd->bhqk', q, k).astype(jnp.float32) * (XM_HEAD_DIM ** -0.5)
    p = jax.nn.softmax(sc, axis=-1)
    o = jnp.einsum('bhqk,bhkd->bhqd', p.astype(v.dtype), v)
    return from_heads(o) @ w_o


def setup_inputs(seed: int = 0) -> dict:
    key = jax.random.key(seed)
    keys = jax.random.split(key, 40)
    counter = [0]

    def nk():
        k = keys[counter[0]]
        counter[0] += 1
        return k

    def dense(shape, fan_in):
        return jax.random.normal(nk(), shape, jnp.float32) * (fan_in ** -0.5)

    def gain(shape):
        return 1.0 + 0.02 * jax.random.normal(nk(), shape, jnp.float32)

    def small(shape, scale):
        return scale * jax.random.normal(nk(), shape, jnp.float32)

    inputs = {}
    inputs['x'] = jax.random.normal(nk(), (BATCH, SEQ, D_MODEL), jnp.float32)
    inputs['mem'] = jax.random.normal(nk(), (BATCH, MEM_LEN, D_MODEL), jnp.float32)
    inputs['ffn_norm'] = gain((DEPTH, 2, D_MODEL))
    inputs['ffn_w_gate'] = dense((DEPTH, 2, D_MODEL, D_FF), D_MODEL)
    inputs['ffn_w_up'] = dense((DEPTH, 2, D_MODEL, D_FF), D_MODEL)
    inputs['ffn_w_down'] = dense((DEPTH, 2, D_FF, D_MODEL), D_FF)
    inputs['mix_norm'] = gain((DEPTH, D_MODEL))
    inputs['ab_w_in'] = dense((N_EVEN, D_MODEL, AB_IN_WIDTH), D_MODEL)
    inputs['ab_w_out'] = dense((N_EVEN, AB_MIX_WIDTH, D_MODEL), AB_MIX_WIDTH)
    inputs['diff_q_norm'] = gain((N_EVEN, DIFF_HEAD_DIM))
    inputs['diff_k_norm'] = gain((N_EVEN, DIFF_HEAD_DIM))
    inputs['diff_lambda_q1'] = small((N_EVEN, DIFF_HEAD_DIM), 0.1)
    inputs['diff_lambda_k1'] = small((N_EVEN, DIFF_HEAD_DIM), 0.1)
    inputs['diff_lambda_q2'] = small((N_EVEN, DIFF_HEAD_DIM), 0.1)
    inputs['diff_lambda_k2'] = small((N_EVEN, DIFF_HEAD_DIM), 0.1)
    inputs['diff_subln'] = gain((N_EVEN, DIFF_V_DIM))
    inputs['mla_w_dq'] = dense((N_ODD, D_MODEL, MLA_Q_RANK), D_MODEL)
    inputs['mla_q_norm'] = gain((N_ODD, MLA_Q_RANK))
    inputs['mla_w_uq'] = dense((N_ODD, MLA_Q_RANK, MLA_HEADS * MLA_QK_DIM), MLA_Q_RANK)
    inputs['mla_w_dkv'] = dense((N_ODD, D_MODEL, MLA_KV_RANK + MLA_ROPE_DIM), D_MODEL)
    inputs['mla_kv_norm'] = gain((N_ODD, MLA_KV_RANK))
    inputs['mla_w_ukv'] = dense((N_ODD, MLA_KV_RANK, MLA_HEADS * (MLA_NOPE_DIM + MLA_V_DIM)), MLA_KV_RANK)
    inputs['mla_qk_norm_q'] = gain((N_ODD, MLA_QK_DIM))
    inputs['mla_qk_norm_k'] = gain((N_ODD, MLA_QK_DIM))
    inputs['mla_w_o'] = dense((N_ODD, MLA_HEADS * MLA_V_DIM, D_MODEL), MLA_HEADS * MLA_V_DIM)
    inputs['xm_norm'] = gain((DEPTH, D_MODEL))
    inputs['xm_mem_norm'] = gain((DEPTH, D_MODEL))
    inputs['xm_w_q'] = dense((DEPTH, D_MODEL, XM_WIDTH), D_MODEL)
    inputs['xm_w_kv'] = dense((DEPTH, D_MODEL, 2 * XM_WIDTH), D_MODEL)
    inputs['xm_q_norm'] = gain((DEPTH, XM_HEAD_DIM))
    inputs['xm_k_norm'] = gain((DEPTH, XM_HEAD_DIM))
    inputs['xm_w_o'] = dense((DEPTH, XM_WIDTH, D_MODEL), XM_WIDTH)
    return inputs


def reference(x, mem, ffn_norm, ffn_w_gate, ffn_w_up, ffn_w_down, mix_norm,
              ab_w_in, ab_w_out, diff_q_norm, diff_k_norm, diff_lambda_q1, diff_lambda_k1,
              diff_lambda_q2, diff_lambda_k2, diff_subln,
              mla_w_dq, mla_q_norm, mla_w_uq, mla_w_dkv, mla_kv_norm, mla_w_ukv,
              mla_qk_norm_q, mla_qk_norm_k, mla_w_o,
              xm_norm, xm_mem_norm, xm_w_q, xm_w_kv, xm_q_norm, xm_k_norm, xm_w_o):
    for layer in range(DEPTH):
        i = layer // 2
        x = x + 0.5 * swiglu(rms_norm(x, ffn_norm[layer, 0]),
                             ffn_w_gate[layer, 0], ffn_w_up[layer, 0], ffn_w_down[layer, 0])
        h = rms_norm(x, mix_norm[layer])
        if layer % 2 == 0:
            lambda_init = 0.8 - 0.6 * math.exp(-0.3 * layer)
            x = x + diff_stickbreak_mixer(h, ab_w_in[i], ab_w_out[i], diff_q_norm[i], diff_k_norm[i],
                                          diff_lambda_q1[i], diff_lambda_k1[i],
                                          diff_lambda_q2[i], diff_lambda_k2[i],
                                          diff_subln[i], lambda_init)
        else:
            x = x + mla_mixer(h, mla_w_dq[i], mla_q_norm[i], mla_w_uq[i], mla_w_dkv[i],
                              mla_kv_norm[i], mla_w_ukv[i], mla_qk_norm_q[i], mla_qk_norm_k[i],
                              mla_w_o[i])
        x = x + memory_cross_attention(rms_norm(x, xm_norm[layer]), rms_norm(mem, xm_mem_norm[layer]),
                                       xm_w_q[layer], xm_w_kv[layer], xm_q_norm[layer],
                                       xm_k_norm[layer], xm_w_o[layer])
        x = x + 0.5 * swiglu(rms_norm(x, ffn_norm[layer, 1]),
                             ffn_w_gate[layer, 1], ffn_w_up[layer, 1], ffn_w_down[layer, 1])
    return x
```

```cpp
#include <hip/hip_runtime.h>
#include <hip/hip_cooperative_groups.h>
#include <cstdio>
#include <cstdint>
namespace cg = cooperative_groups;

#define LAS __attribute__((address_space(3)))
typedef unsigned short bf16_t;
typedef short bf16x8 __attribute__((ext_vector_type(8)));
typedef short s16x4 __attribute__((ext_vector_type(4)));
typedef float f32x4 __attribute__((ext_vector_type(4)));
typedef float f32x16 __attribute__((ext_vector_type(16)));
typedef unsigned u32x4 __attribute__((ext_vector_type(4)));
typedef unsigned u32x2 __attribute__((ext_vector_type(2)));
typedef float f32x2_t __attribute__((ext_vector_type(2)));
typedef __bf16 bf16x2_t __attribute__((ext_vector_type(2)));


__device__ __forceinline__ int lane_now() { int l; asm volatile("v_mbcnt_lo_u32_b32 %0, -1, 0\n\tv_mbcnt_hi_u32_b32 %0, -1, %0" : "=v"(l)); return l; }

__device__ __forceinline__ float ssq_sum(const float* p) {
    const f32x4 a = *(const f32x4*)p, b = *(const f32x4*)(p + 4), c = *(const f32x4*)(p + 8), d = *(const f32x4*)(p + 12);
    return (((a[0] + a[1]) + (a[2] + a[3])) + ((b[0] + b[1]) + (b[2] + b[3]))) + (((c[0] + c[1]) + (c[2] + c[3])) + ((d[0] + d[1]) + (d[2] + d[3])));
}

__device__ __forceinline__ float fadd_s(float a, float b) { float r = a + b; asm("" : "+v"(r)); return r; }
__device__ __forceinline__ float fmul_s(float a, float b) { float r = a * b; asm("" : "+v"(r)); return r; }
constexpr int DM = 1024, NB = 8, SEQ = 4096, MTOK = NB * SEQ, DFF = 2816, MEMLEN = 256, MMEM = NB * MEMLEN;
constexpr float EPS = 1e-6f;
constexpr float LOG2E = 1.4426950408889634f;

__device__ __forceinline__ unsigned cvtpk(float lo, float hi) { f32x2_t v = {lo, hi}; bf16x2_t b = __builtin_convertvector(v, bf16x2_t); return __builtin_bit_cast(unsigned, b); }
__device__ __forceinline__ float bf2f(unsigned short h) { return __uint_as_float(((unsigned)h) << 16); }
__device__ __forceinline__ float bflo(unsigned w) { return __uint_as_float(w << 16); }
__device__ __forceinline__ float bfhi(unsigned w) { return __uint_as_float(w & 0xffff0000u); }

__device__ const double ROPE_REV[32] = {0.15915494309189535, 0.11934937021124886, 0.08949940160889101, 0.06711508300522726, 0.050329212104487035, 0.03774158471741977, 0.0283021958306234, 0.02122365276477766, 0.015915494309189534, 0.011934937021124886, 0.008949940160889102, 0.006711508300522725, 0.005032921210448704, 0.003774158471741977, 0.00283021958306234, 0.0021223652764777662, 0.0015915494309189536, 0.0011934937021124885, 0.0008949940160889102, 0.0006711508300522726, 0.0005032921210448703, 0.00037741584717419774, 0.00028302195830623395, 0.0002122365276477766, 0.00015915494309189535, 0.00011934937021124886, 8.949940160889102e-05, 6.711508300522725e-05, 5.0329212104487035e-05, 3.774158471741978e-05, 2.8302195830623396e-05, 2.122365276477766e-05};
__device__ __forceinline__ void rope_cs(int pos, int idx64, float& cs, float& sn) {
    const double rev = (double)pos * ROPE_REV[idx64];
    const float fr = (float)(rev - __builtin_rint(rev));
    cs = __builtin_amdgcn_cosf(fr); sn = __builtin_amdgcn_sinf(fr);
    asm volatile("" : "+v"(cs), "+v"(sn));
}

namespace pg8 {
constexpr int BM = 256, BK = 64, HALF = 128, HTB = HALF * BK * 2, STAGE_BYTES = 8 * HTB, NXCD = 8, WGM = 8;
__device__ __forceinline__ int lds_byte(int r, int c) { const int st = (r >> 4) * 2 + (c >> 5), rr = r & 15, cc = c & 31, ob = rr * 64 + cc * 2; return st * 1024 + (ob ^ (((ob >> 9) & 1) << 5)); }
__device__ __forceinline__ void stage_rc(int b, int& R, int& C) { const int st = b / 1024, sb = b % 1024, swz = sb ^ (((sb >> 9) & 1) << 5); R = (st >> 1) * 16 + swz / 64; C = (st & 1) * 32 + (swz % 64) / 2; }
__device__ __forceinline__ int perm32(int rho) { const int n = rho >> 4, i = rho & 15; return 8 * (i >> 2) + 4 * n + (i & 3); }
struct Unit { int pm, pn; };
struct Gemm { const bf16_t* A; const bf16_t* Bt; int M, N, K, lda, ldb; };
struct StaticOrder {
    int nM, nN, nwg, G, c;
    __device__ void init(int M, int N, int G_, int c_) { nM = M / BM; nN = N / BM; nwg = nM * nN; G = G_; c = c_; }
    __device__ bool next(int i, Unit& u) const {
        const long L = (long)i * G + c; if (L >= nwg) return false;
        int wgid = (int)L; { const int q = nwg / NXCD, r = nwg % NXCD, xcd = wgid % NXCD, off = wgid / NXCD; wgid = (xcd < r ? xcd * (q + 1) : r * (q + 1) + (xcd - r) * q) + off; }
        const int nig = WGM * nN, gid = wgid / nig, fm = gid * WGM, gsz = (nM - fm) < WGM ? (nM - fm) : WGM;
        u.pm = fm + ((wgid % nig) % gsz); u.pn = (wgid % nig) / gsz; return true;
    }
};
template <class Epi>
__device__ __forceinline__ void gemm_phase(LAS unsigned char* lds, const Gemm g, const StaticOrder& S, const Epi& E, int wave_s) {
    const int tid = wave_s * 64 + lane_now(), wid = __builtin_amdgcn_readfirstlane(tid >> 6), lane = tid & 63, wr = wid >> 2, wc = wid & 3, fr = lane & 15, fq = lane >> 4;
    const int K = g.K, nt = K / BK;
    unsigned voffA[2], voffB[2];
#pragma unroll
    for (int i = 0; i < 2; ++i) { int R, C; stage_rc(tid * 16 + i * 8192, R, C); const int Rb = (R & ~31) + perm32(R & 31);
        voffA[i] = (unsigned)(R * g.lda + C) * 2u; voffB[i] = (unsigned)(Rb * g.ldb + C) * 2u; }
    const size_t kstep = (size_t)(BK * 2);
    const size_t hstepA = (size_t)HALF * g.lda * 2, hstepB = (size_t)HALF * g.ldb * 2;
    const size_t tstepA = 2 * hstepA, tstepB = 2 * hstepB;
    const unsigned ldsw = (unsigned)wid * 1024u;
    const int aoff = lds_byte(wr * 64 + fr, fq * 8), boff = lds_byte(wc * 32 + fr, fq * 8);
#define PG8_SA(b, h) (((b) * 2 + (h)) * HTB)
#define PG8_SB(b, h) ((4 + (b) * 2 + (h)) * HTB)
#define PG8_STAGE(bufoff, gbase, voff) do { _Pragma("unroll") for (int _i = 0; _i < 2; ++_i) \
        __builtin_amdgcn_global_load_lds((const unsigned*)((const char*)(gbase) + (voff)[_i]), (LAS unsigned*)(lds + (bufoff) + ldsw + _i * 8192), 16, 0, 0); } while (0)
#define PG8_LDA(dst, b, h) do { _Pragma("unroll") for (int m = 0; m < 4; ++m) _Pragma("unroll") for (int k = 0; k < 2; ++k) dst[m][k] = *(const LAS bf16x8*)(lds + PG8_SA(b, h) + aoff + m * 2048 + k * 1024); } while (0)
#define PG8_LDB(dst, b, h) do { _Pragma("unroll") for (int n = 0; n < 2; ++n) _Pragma("unroll") for (int k = 0; k < 2; ++k) dst[n][k] = *(const LAS bf16x8*)(lds + PG8_SB(b, h) + boff + n * 2048 + k * 1024); } while (0)
#define PG8_MMA(ai, bj, At, Bt) do { __builtin_amdgcn_s_setprio(1); _Pragma("unroll") for (int m = 0; m < 4; ++m) _Pragma("unroll") for (int n = 0; n < 2; ++n) _Pragma("unroll") for (int k = 0; k < 2; ++k) \
        acc[ai][bj][m][n] = __builtin_amdgcn_mfma_f32_16x16x32_bf16(Bt[n][k], At[m][k], acc[ai][bj][m][n], 0, 0, 0); __builtin_amdgcn_s_setprio(0); } while (0)
#define PG8_WAIT_V(n) asm volatile("s_waitcnt vmcnt(" #n ")" ::: "memory")
#define PG8_WAIT_L(n) asm volatile("s_waitcnt lgkmcnt(" #n ")" ::: "memory")
#define PG8_BAR __builtin_amdgcn_s_barrier()
#define PG8_SCHED __builtin_amdgcn_sched_barrier(0)
    Unit cur, nxt; int ui = 0;
    if (!S.next(0, cur)) return;
    f32x4 acc[2][2][4][2];
#pragma unroll
    for (int a = 0; a < 2; ++a)
#pragma unroll
        for (int b = 0; b < 2; ++b)
#pragma unroll
            for (int m = 0; m < 4; ++m)
#pragma unroll
                for (int n = 0; n < 2; ++n) acc[a][b][m][n] = (f32x4){0.f, 0.f, 0.f, 0.f};
    bf16x8 At[4][2], B0[2][2], B1[2][2];
    const char* cA = (const char*)g.A + (size_t)cur.pm * tstepA; const char* cB = (const char*)g.Bt + (size_t)cur.pn * tstepB;
    PG8_STAGE(PG8_SB(0, 0), cB, voffB); PG8_STAGE(PG8_SB(0, 1), cB + hstepB, voffB); PG8_STAGE(PG8_SA(0, 0), cA, voffA); PG8_STAGE(PG8_SA(0, 1), cA + hstepA, voffA);
    if (wr == 1) PG8_BAR;
    PG8_WAIT_V(2); PG8_BAR;
    PG8_STAGE(PG8_SB(1, 0), cB + kstep, voffB); PG8_STAGE(PG8_SA(1, 0), cA + kstep, voffA); PG8_STAGE(PG8_SB(1, 1), cB + hstepB + kstep, voffB);
    PG8_WAIT_V(6); PG8_BAR;
    for (;;) {
        const bool has_next = S.next(ui + 1, nxt);
        const char* nA = has_next ? (const char*)g.A + (size_t)nxt.pm * tstepA : cA; const char* nB = has_next ? (const char*)g.Bt + (size_t)nxt.pn * tstepB : cB;
        for (int t = 0; t < nt; t += 2) {
            const bool last = (t == nt - 2);
            const char* a1 = cA + (size_t)(t + 1) * kstep;
            const char* a2 = last ? nA : cA + (size_t)(t + 2) * kstep; const char* b2 = last ? nB : cB + (size_t)(t + 2) * kstep;
            const char* a3 = a2 + kstep; const char* b3 = b2 + kstep;
            PG8_LDB(B0, 0, 0); PG8_LDB(B1, 0, 1); PG8_SCHED; PG8_LDA(At, 0, 0); PG8_STAGE(PG8_SA(1, 1), a1 + hstepA, voffA);
            PG8_WAIT_V(8); PG8_WAIT_L(0); PG8_BAR; PG8_MMA(0, 0, At, B0); PG8_MMA(0, 1, At, B1); PG8_BAR; PG8_SCHED;
            PG8_LDA(At, 0, 1); PG8_STAGE(PG8_SB(0, 0), b2, voffB); PG8_STAGE(PG8_SB(0, 1), b2 + hstepB, voffB); PG8_STAGE(PG8_SA(0, 0), a2, voffA);
            PG8_WAIT_V(8); PG8_WAIT_L(0); PG8_BAR; PG8_MMA(1, 0, At, B0); PG8_MMA(1, 1, At, B1); PG8_BAR; PG8_SCHED;
            PG8_LDB(B0, 1, 0); PG8_LDB(B1, 1, 1); PG8_SCHED; PG8_LDA(At, 1, 0); PG8_STAGE(PG8_SA(0, 1), a2 + hstepA, voffA);
            PG8_WAIT_V(8); PG8_WAIT_L(0); PG8_BAR; PG8_MMA(0, 0, At, B0); PG8_MMA(0, 1, At, B1); PG8_BAR; PG8_SCHED;
            PG8_LDA(At, 1, 1); PG8_STAGE(PG8_SB(1, 0), b3, voffB); PG8_STAGE(PG8_SB(1, 1), b3 + hstepB, voffB); PG8_STAGE(PG8_SA(1, 0), a3, voffA);
            PG8_WAIT_V(8); PG8_WAIT_L(0); PG8_BAR; PG8_MMA(1, 0, At, B0); PG8_MMA(1, 1, At, B1); PG8_BAR; PG8_SCHED;
        }
        if (wr == 0) PG8_BAR;
        E(acc, cur, wr, wc, fr, fq);
        if (!has_next) break;
#pragma unroll
        for (int a = 0; a < 2; ++a)
#pragma unroll
            for (int b = 0; b < 2; ++b)
#pragma unroll
                for (int m = 0; m < 4; ++m)
#pragma unroll
                    for (int n = 0; n < 2; ++n) acc[a][b][m][n] = (f32x4){0.f, 0.f, 0.f, 0.f};
        cur = nxt; cA = nA; cB = nB; ++ui;
        if (wr == 1) PG8_BAR;
    }
    PG8_WAIT_V(0);
    PG8_BAR;
#undef PG8_SA
#undef PG8_SB
#undef PG8_STAGE
#undef PG8_LDA
#undef PG8_LDB
#undef PG8_MMA
#undef PG8_WAIT_V
#undef PG8_WAIT_L
#undef PG8_BAR
#undef PG8_SCHED
}

struct EpiSwiGLU {
    bf16_t* H; const float* ssq;
    __device__ __forceinline__ void operator()(const f32x4 (&acc)[2][2][4][2], const Unit& u, int wr, int wc, int fr, int fq) const {
        const int row0 = u.pm * BM + wr * 64 + fr, col0 = u.pn * 128 + wc * 32 + 8 * fq;
#pragma unroll
        for (int ai = 0; ai < 2; ++ai)
#pragma unroll
            for (int m = 0; m < 4; ++m) {
                const int row = row0 + ai * HALF + m * 16;
                const float rs = 1.0f / sqrtf(ssq_sum(ssq + (size_t)row * 16) * (1.0f / DM) + EPS);
                float hv[8];
#pragma unroll
                for (int n = 0; n < 2; ++n)
#pragma unroll
                    for (int e = 0; e < 4; ++e) {
                        const float gg = acc[ai][0][m][n][e] * rs, uu = acc[ai][1][m][n][e] * rs;
                        const float den = 1.0f + __builtin_amdgcn_exp2f(-gg * LOG2E);
                        hv[n * 4 + e] = gg * uu * __builtin_amdgcn_rcpf(den);
                    }
                u32x4 w; w.x = cvtpk(hv[0], hv[1]); w.y = cvtpk(hv[2], hv[3]); w.z = cvtpk(hv[4], hv[5]); w.w = cvtpk(hv[6], hv[7]);
                *(u32x4*)(H + (size_t)row * DFF + col0) = w;
            }
    }
};
template <int RM> struct EpiResidB {
    const float* xf; float* outf; bf16_t* xb; float* ssq_out; float alpha;
    __device__ __forceinline__ void operator()(const f32x4 (&acc)[2][2][4][2], const Unit& u, int wr, int wc, int fr, int fq) const {
        const int row0 = u.pm * BM + wr * 64 + fr, col0 = u.pn * BM + wc * 32 + 8 * fq;
        u32x4 xv[RM == 0 ? 1 : 2][RM == 0 ? 1 : 4][RM == 0 ? 1 : 2];
        if (RM != 0) {
#pragma unroll
            for (int ai = 0; ai < 2; ++ai)
#pragma unroll
                for (int m = 0; m < 4; ++m)
#pragma unroll
                    for (int bj = 0; bj < 2; ++bj) xv[RM == 0 ? 0 : ai][RM == 0 ? 0 : m][RM == 0 ? 0 : bj] = *(const u32x4*)(xb + (size_t)(row0 + ai * HALF + m * 16) * DM + col0 + bj * HALF);
        }
#pragma unroll
        for (int ai = 0; ai < 2; ++ai)
#pragma unroll
            for (int m = 0; m < 4; ++m) {
                const int row = row0 + ai * HALF + m * 16; float s = 0.f;
#pragma unroll
                for (int bj = 0; bj < 2; ++bj) {
                    const size_t off = (size_t)row * DM + col0 + bj * HALF;
                    f32x4 v0, v1;
                    if (RM == 0) { v0 = *(const f32x4*)(xf + off); v1 = *(const f32x4*)(xf + off + 4); }
                    else { const u32x4 w = xv[RM == 0 ? 0 : ai][RM == 0 ? 0 : m][RM == 0 ? 0 : bj]; v0 = (f32x4){bflo(w.x), bfhi(w.x), bflo(w.y), bfhi(w.y)}; v1 = (f32x4){bflo(w.z), bfhi(w.z), bflo(w.w), bfhi(w.w)}; }
                    v0 = v0 + acc[ai][bj][m][0] * alpha; v1 = v1 + acc[ai][bj][m][1] * alpha;
                    if (RM == 2) { *(f32x4*)(outf + off) = v0; *(f32x4*)(outf + off + 4) = v1; }
                    else {
                        u32x4 w; w.x = cvtpk(v0[0], v0[1]); w.y = cvtpk(v0[2], v0[3]); w.z = cvtpk(v1[0], v1[1]); w.w = cvtpk(v1[2], v1[3]);
                        *(u32x4*)(xb + off) = w;
                        s += (v0[0] * v0[0] + v0[1] * v0[1]) + (v0[2] * v0[2] + v0[3] * v0[3]) + (v1[0] * v1[0] + v1[1] * v1[1]) + (v1[2] * v1[2] + v1[3] * v1[3]);
                    }
                }
                if (RM != 2) { s += __shfl_xor(s, 16); s += __shfl_xor(s, 32); if (fq == 0) ssq_out[(size_t)row * 16 + u.pn * 4 + wc] = s; }
            }
    }
};
struct EpiOut {
    bf16_t* O; int ldc; const float* ssq_in; float inv_dim; int hd_in, hd_out; float* ssq_o[4];
    __device__ __forceinline__ void operator()(const f32x4 (&acc)[2][2][4][2], const Unit& u, int wr, int wc, int fr, int fq) const {
        const int row0 = u.pm * BM + wr * 64 + fr, col0 = u.pn * BM + wc * 32 + 8 * fq;
        float* so = (u.pn == 0) ? ssq_o[0] : (u.pn == 1) ? ssq_o[1] : (u.pn == 2) ? ssq_o[2] : (u.pn == 3) ? ssq_o[3] : nullptr;
#pragma unroll
        for (int ai = 0; ai < 2; ++ai)
#pragma unroll
            for (int m = 0; m < 4; ++m) {
                const int row = row0 + ai * HALF + m * 16; float s = 0.f;
                const float rs = ssq_in ? 1.0f / sqrtf(ssq_sum(ssq_in + (size_t)row * 16) * inv_dim + EPS) : 1.0f;
#pragma unroll
                for (int bj = 0; bj < 2; ++bj) {
                    int col = col0 + bj * HALF; if (hd_in) col = (col / hd_in) * hd_out + (col % hd_in);
                    const f32x4 v0 = acc[ai][bj][m][0] * rs, v1 = acc[ai][bj][m][1] * rs;
                    u32x4 w; w.x = cvtpk(v0[0], v0[1]); w.y = cvtpk(v0[2], v0[3]); w.z = cvtpk(v1[0], v1[1]); w.w = cvtpk(v1[2], v1[3]);
                    *(u32x4*)(O + (size_t)row * ldc + col) = w;
                    s += (v0[0] * v0[0] + v0[1] * v0[1]) + (v0[2] * v0[2] + v0[3] * v0[3]) + (v1[0] * v1[0] + v1[1] * v1[1]) + (v1[2] * v1[2] + v1[3] * v1[3]);
                }
                if (so) { s += __shfl_xor(s, 16); s += __shfl_xor(s, 32); if (fq == 0) so[(size_t)row * 16 + (u.pn & 1) * 4 + wc] = s; }
            }
    }
};
struct EpiOutT {
    bf16_t* O; int ldc; const float* ssq_in; float inv_dim;
    __device__ __forceinline__ void operator()(const f32x4 (&acc)[2][2][4][2], const Unit& u, int wr, int wc, int fr, int fq) const {
        const int row0 = u.pm * BM + wr * 64 + fr, col0 = u.pn * BM + wc * 32 + 8 * fq;
        f32x4 cs[2][2];
#pragma unroll
        for (int bj = 0; bj < 2; ++bj)
#pragma unroll
            for (int n = 0; n < 2; ++n) {
#pragma unroll
                for (int e = 0; e < 4; ++e) cs[bj][n][e] = 1.0f / sqrtf(ssq_sum(ssq_in + (size_t)(col0 + bj * HALF + 4 * n + e) * 16) * inv_dim + EPS); }
#pragma unroll
        for (int ai = 0; ai < 2; ++ai)
#pragma unroll
            for (int m = 0; m < 4; ++m) {
                const int row = row0 + ai * HALF + m * 16;
#pragma unroll
                for (int bj = 0; bj < 2; ++bj) {
                    const f32x4 v0 = acc[ai][bj][m][0] * cs[bj][0], v1 = acc[ai][bj][m][1] * cs[bj][1];
                    u32x4 w; w.x = cvtpk(v0[0], v0[1]); w.y = cvtpk(v0[2], v0[3]); w.z = cvtpk(v1[0], v1[1]); w.w = cvtpk(v1[2], v1[3]);
                    *(u32x4*)(O + (size_t)row * ldc + col0 + bj * HALF) = w;
                }
            }
    }
};

struct EpiQK0 {
    bf16_t* O; const float* ssq_in; const float* gq; const float* gk; float qscale;
    __device__ __forceinline__ void operator()(const f32x4 (&acc)[2][2][4][2], const Unit& u, int wr, int wc, int fr, int fq) const {
        { const int l_ = lane_now(); fq = l_ >> 4; fr = l_ & 15; }
        const int row0 = u.pm * BM + wr * 64 + fr;
        if (u.pn >= 4) {
            const int col0 = u.pn * BM + wc * 32 + 8 * fq;
#pragma unroll
            for (int ai = 0; ai < 2; ++ai)
#pragma unroll
                for (int m = 0; m < 4; ++m) {
                    const int row = row0 + ai * HALF + m * 16;
                    const float rs = (u.pn < 6 ? qscale : 1.0f) / sqrtf(ssq_sum(ssq_in + (size_t)row * 16) * (1.0f / DM) + EPS);
#pragma unroll
                    for (int bj = 0; bj < 2; ++bj) {
                        const f32x4 v0 = acc[ai][bj][m][0] * rs, v1 = acc[ai][bj][m][1] * rs;
                        u32x4 w; w.x = cvtpk(v0[0], v0[1]); w.y = cvtpk(v0[2], v0[3]); w.z = cvtpk(v1[0], v1[1]); w.w = cvtpk(v1[2], v1[3]);
                        *(u32x4*)(O + (size_t)row * 2048 + col0 + bj * HALF) = w;
                    }
                }
            return;
        }
        const int head = u.pn * 4 + wc;
        const float* g = (head < 8 ? gq : gk) + 8 * fq;
        f32x4 gv[2][2];
#pragma unroll
        for (int bj = 0; bj < 2; ++bj)
#pragma unroll
            for (int n = 0; n < 2; ++n) gv[bj][n] = *(const f32x4*)(g + bj * 32 + 4 * n);
#pragma unroll
        for (int ai = 0; ai < 2; ++ai)
#pragma unroll
            for (int m = 0; m < 4; ++m) {
                const int row = row0 + ai * HALF + m * 16; const int pos = row & (SEQ - 1);
                float s = 0.f;
#pragma unroll
                for (int bj = 0; bj < 2; ++bj)
#pragma unroll
                    for (int n = 0; n < 2; ++n) { const f32x4 v = acc[ai][bj][m][n]; s += (v[0] * v[0] + v[1] * v[1]) + (v[2] * v[2] + v[3] * v[3]); }
                s += __shfl_xor(s, 16); s += __shfl_xor(s, 32);
                const float rx = 1.0f / sqrtf(ssq_sum(ssq_in + (size_t)row * 16) * (1.0f / DM) + EPS);
                const float rs = (head < 8 ? qscale : 1.0f) * rx / sqrtf(s * rx * rx * (1.0f / 64.0f) + EPS);
                float o1[8], o2[8];
#pragma unroll
                for (int n = 0; n < 2; ++n)
#pragma unroll
                    for (int e = 0; e < 4; ++e) {
                        float cs, sn; rope_cs(pos, 8 * fq + 4 * n + e, cs, sn);
                        const float x1 = acc[ai][0][m][n][e] * rs * gv[0][n][e], x2 = acc[ai][1][m][n][e] * rs * gv[1][n][e];
                        o1[4 * n + e] = x1 * cs - x2 * sn; o2[4 * n + e] = x1 * sn + x2 * cs;
                    }
                bf16_t* op = O + (size_t)row * 2048 + head * 64 + 8 * fq;
                u32x4 w; w.x = cvtpk(o1[0], o1[1]); w.y = cvtpk(o1[2], o1[3]); w.z = cvtpk(o1[4], o1[5]); w.w = cvtpk(o1[6], o1[7]);
                *(u32x4*)op = w;
                w.x = cvtpk(o2[0], o2[1]); w.y = cvtpk(o2[2], o2[3]); w.z = cvtpk(o2[4], o2[5]); w.w = cvtpk(o2[6], o2[7]);
                *(u32x4*)(op + 32) = w;
                asm volatile("" ::: "memory");
            }
    }
};
struct EpiK1 {
    bf16_t* O; const bf16_t* T1; const float* ssq_in; const float* gk;
    __device__ __forceinline__ void operator()(const f32x4 (&acc)[2][2][4][2], const Unit& u, int wr, int wc, int fr, int fq) const {
        { const int l_ = lane_now(); fq = l_ >> 4; fr = l_ & 15; }
        const int row0 = u.pm * BM + wr * 64 + fr;
        const int head = u.pn * 4 + wc;
        float rhs[8];
#pragma unroll
        for (int ai = 0; ai < 2; ++ai)
#pragma unroll
            for (int m = 0; m < 4; ++m) {
                const int row = row0 + ai * HALF + m * 16;
                const float rkv = 1.0f / sqrtf(ssq_sum(ssq_in + (size_t)row * 16) * (1.0f / 256.0f) + EPS);
                const u32x4 kw = *(const u32x4*)(T1 + (size_t)row * 1024 + 768 + 8 * fq);
                float s = (bflo(kw.x) * bflo(kw.x) + bfhi(kw.x) * bfhi(kw.x)) + (bflo(kw.y) * bflo(kw.y) + bfhi(kw.y) * bfhi(kw.y))
                        + (bflo(kw.z) * bflo(kw.z) + bfhi(kw.z) * bfhi(kw.z)) + (bflo(kw.w) * bflo(kw.w) + bfhi(kw.w) * bfhi(kw.w));
#pragma unroll
                for (int bj = 0; bj < 2; ++bj)
#pragma unroll
                    for (int n = 0; n < 2; ++n) { const f32x4 v = acc[ai][bj][m][n] * rkv; s += (v[0] * v[0] + v[1] * v[1]) + (v[2] * v[2] + v[3] * v[3]); }
                s += __shfl_xor(s, 16); s += __shfl_xor(s, 32);
                const float rh = 1.0f / sqrtf(s * (1.0f / 96.0f) + EPS), rs = rkv * rh;
                rhs[ai * 4 + m] = rh;
                bf16_t* op = O + (size_t)row * 1536 + head * 96;
#pragma unroll
                for (int bj = 0; bj < 2; ++bj) {
                    const f32x4 g0 = *(const f32x4*)(gk + bj * 32 + 8 * fq), g1 = *(const f32x4*)(gk + bj * 32 + 8 * fq + 4);
                    const f32x4 v0 = acc[ai][bj][m][0] * rs * g0, v1 = acc[ai][bj][m][1] * rs * g1;
                    u32x4 w; w.x = cvtpk(v0[0], v0[1]); w.y = cvtpk(v0[2], v0[3]); w.z = cvtpk(v1[0], v1[1]); w.w = cvtpk(v1[2], v1[3]);
                    *(u32x4*)(op + bj * 32 + 8 * fq) = w;
                }
                asm volatile("" ::: "memory");
            }
        const f32x4 gr0 = *(const f32x4*)(gk + 64 + 8 * fq), gr1 = *(const f32x4*)(gk + 64 + 8 * fq + 4);
#pragma unroll
        for (int ai = 0; ai < 2; ++ai)
#pragma unroll
            for (int m = 0; m < 4; ++m) {
                const int row = row0 + ai * HALF + m * 16; const int pos = row & (SEQ - 1);
                const float rh = rhs[ai * 4 + m];
                const u32x4 kw = *(const u32x4*)(T1 + (size_t)row * 1024 + 768 + 8 * fq);
                const float kr[8] = {bflo(kw.x), bfhi(kw.x), bflo(kw.y), bfhi(kw.y), bflo(kw.z), bfhi(kw.z), bflo(kw.w), bfhi(kw.w)};
                float ro[8];
#pragma unroll
                for (int j = 0; j < 8; ++j) {
                    const float x = kr[j] * rh * (j < 4 ? gr0[j & 3] : gr1[j & 3]);
                    const float px = __shfl_xor(x, 32);
                    float cs, sn; rope_cs(pos, 2 * (8 * (fq & 1) + j), cs, sn);
                    ro[j] = (fq < 2) ? (x * cs - px * sn) : (px * sn + x * cs);
                }
                u32x4 w; w.x = cvtpk(ro[0], ro[1]); w.y = cvtpk(ro[2], ro[3]); w.z = cvtpk(ro[4], ro[5]); w.w = cvtpk(ro[6], ro[7]);
                *(u32x4*)(O + (size_t)row * 1536 + head * 96 + 64 + 8 * fq) = w;
                asm volatile("" ::: "memory");
            }
    }
};
}

__device__ __forceinline__ void swap32(float x, float& lo, float& hi_) {
    auto rr = __builtin_amdgcn_permlane32_swap(__float_as_uint(x), __float_as_uint(x), false, false);
    lo = __uint_as_float(rr[0]); hi_ = __uint_as_float(rr[1]);
}
template <int DQK, int DV, int MODE, int QPRE, bool DIFF>
__device__ __forceinline__ void attn_unit(LAS unsigned char* lds, const bf16_t* __restrict__ Q, int ldq, const bf16_t* __restrict__ Kp0, int ldk,
                                          const bf16_t* __restrict__ VT, int ldvt, bf16_t* __restrict__ O, int ldo, int q0, int nkt, float c  ,
                                          const float* __restrict__ qg, const float* __restrict__ subln, float lam, float post, int wave_s) {
    constexpr int KST = DQK * 2 + 16, VST = 144, KBUF = 64 * KST, VBUF = DV * VST, BUF = KBUF + VBUF;
    constexpr int KCH = DQK / 8, NKC = 64 * KCH, NKL = (NKC + 511) / 512, NVC = DV * 8, NVL = NVC / 512, ND0 = DQK / 16, NDB = DV / 32;
    static_assert(BUF % 16 == 0 && (DV == 64 ? 4 : 2) * BUF <= 131072, "lds");
    const int lane = lane_now(), wid = wave_s, tid = wid * 64 + lane, l32 = lane & 31, hi = lane >> 5;
    LAS unsigned* o1l = (LAS unsigned*)(lds + 65536 + wid * 8192) + lane;
    static_assert(!DIFF || 2 * BUF <= 65536, "o1 park");
    const int my_last = (MODE == 2) ? (nkt - 1) : ((q0 + wid * 32) >> 6);
#pragma unroll 1
    for (int mp = 0; mp < (DIFF ? 2 : 1); ++mp) {
    const bf16_t* Kp = Kp0 + mp * 256;
    bf16x8 qf[ND0];
    { const bf16_t* qrow = Q + mp * 256 + (size_t)(q0 + wid * 32 + l32) * ldq + hi * 8;
#pragma unroll
      for (int d0 = 0; d0 < ND0; ++d0) qf[d0] = *(const bf16x8*)(qrow + d0 * 16); }
    if (QPRE != 0) {
        float v[ND0][8]; float s = 0.f;
#pragma unroll
        for (int d0 = 0; d0 < ND0; ++d0)
#pragma unroll
            for (int j = 0; j < 8; ++j) { v[d0][j] = bf2f((unsigned short)qf[d0][j]); s += v[d0][j] * v[d0][j]; }
        { float a, b; swap32(s, a, b); s = a + b; }
        const float rs = 1.0f / sqrtf(s * (1.0f / DQK) + EPS);
#pragma unroll
        for (int d0 = 0; d0 < ND0; ++d0) { const f32x4 g0 = *(const f32x4*)(qg + d0 * 16 + hi * 8), g1 = *(const f32x4*)(qg + d0 * 16 + hi * 8 + 4);
#pragma unroll
            for (int j = 0; j < 4; ++j) { v[d0][j] *= rs * c * g0[j]; v[d0][4 + j] *= rs * c * g1[j]; } }
        if (QPRE == 3) {
            const int pos = q0 + wid * 32 + l32;
#pragma unroll
            for (int j = 0; j < 8; ++j) { float cs, sn; rope_cs(pos, 2 * (8 * hi + j), cs, sn); const float x1 = v[ND0 - 2][j], x2 = v[ND0 - 1][j];
                v[ND0 - 2][j] = x1 * cs - x2 * sn; v[ND0 - 1][j] = x1 * sn + x2 * cs; }
        }
#pragma unroll
        for (int d0 = 0; d0 < ND0; ++d0) { u32x4 w; w.x = cvtpk(v[d0][0], v[d0][1]); w.y = cvtpk(v[d0][2], v[d0][3]); w.z = cvtpk(v[d0][4], v[d0][5]); w.w = cvtpk(v[d0][6], v[d0][7]); qf[d0] = __builtin_bit_cast(bf16x8, w); }
    }
    f32x16 o[NDB];
#pragma unroll
    for (int i = 0; i < NDB; ++i)
#pragma unroll
        for (int r = 0; r < 16; ++r) o[i][r] = 0.f;
    float mhat = 0.f, Rp = 1.0f;
    f32x16 lacc;
#pragma unroll
    for (int r = 0; r < 16; ++r) lacc[r] = 0.f;
    bool sb_done = false;
    f32x16 negm;
#pragma unroll
    for (int r = 0; r < 16; ++r) negm[r] = 0.f;
    constexpr bool DEEP = (DV == 64);
    u32x4 kreg[DEEP ? 4 : 1][NKL], vreg[DEEP ? 4 : 1][NVL];
#define ATT_TILE(i) ((MODE == 1) ? (nkt - 1 - (i)) : (i))
    unsigned kof[NKL], vof[NVL];
#pragma unroll
    for (int j = 0; j < NKL; ++j) { const int ci = tid + 512 * j; const int row = ci / KCH, cc = ci % KCH; kof[j] = (unsigned)(row * ldk + cc * 8); }
#pragma unroll
    for (int j = 0; j < NVL; ++j) { const int ci = tid + 512 * j; const int d = ci >> 3, cc = ci & 7; vof[j] = (unsigned)(d * ldvt + cc * 8); }
#define ATT_LOADG(t, rs) do { const bf16_t* kt_ = Kp + (size_t)(t) * 64 * ldk; const bf16_t* vt_ = VT + (size_t)(t) * 64; \
    _Pragma("unroll") for (int j = 0; j < NKL; ++j) { const int ci = tid + 512 * j; if (NKC % 512 == 0 || ci < NKC) kreg[rs][j] = *(const u32x4*)(kt_ + kof[j]); } \
    _Pragma("unroll") for (int j = 0; j < NVL; ++j) vreg[rs][j] = *(const u32x4*)(vt_ + vof[j]); } while (0)
#define ATT_STORE(b, rs) do { LAS unsigned char* kb_ = lds + (b) * BUF; LAS unsigned char* vb_ = kb_ + KBUF; \
    _Pragma("unroll") for (int j = 0; j < NKL; ++j) { const int ci = tid + 512 * j; if (NKC % 512 == 0 || ci < NKC) { const int row = ci / KCH, cc = ci % KCH; \
        *(LAS u32x4*)(kb_ + row * KST + cc * 16) = kreg[rs][j]; } } \
    _Pragma("unroll") for (int j = 0; j < NVL; ++j) { const int ci = tid + 512 * j; const int d = ci >> 3, cc = ci & 7; \
        *(LAS u32x2*)(vb_ + d * VST + (cc >> 1) * 32 + (cc & 1) * 8) = (u32x2){vreg[rs][j].x, vreg[rs][j].y}; *(LAS u32x2*)(vb_ + d * VST + (cc >> 1) * 32 + (cc & 1) * 8 + 16) = (u32x2){vreg[rs][j].z, vreg[rs][j].w}; } } while (0)
#define ATT_BAR() do { asm volatile("s_waitcnt lgkmcnt(0)" ::: "memory"); __builtin_amdgcn_s_barrier(); asm volatile("" ::: "memory"); } while (0)
    ATT_LOADG(ATT_TILE(0), 0); if (DEEP) { ATT_LOADG(ATT_TILE(1), (DEEP ? 1 : 0)); ATT_LOADG(ATT_TILE(2), (DEEP ? 2 : 0)); ATT_LOADG(ATT_TILE(3), (DEEP ? 3 : 0)); }
    LAS unsigned* sbcnt = (LAS unsigned*)(lds + 131072 + 32);
    if (MODE == 1 && wid == 0 && lane == 0) *sbcnt = 0u;
    bool sb_stop = false;
    ATT_STORE(0, 0); if (DEEP) ATT_STORE(1, (DEEP ? 1 : 0)); ATT_BAR();
    int pp = 0;
    constexpr int UNR = DEEP ? 2 : 1;
    constexpr bool QKFIRST = (MODE == 1);
    constexpr int NPH = DEEP ? 2 : 1;
    for (int i00 = 0; i00 < nkt && !sb_stop; i00 += UNR * NPH) {
#pragma unroll
    for (int ph = 0; ph < NPH; ++ph) {
    const int i0 = i00 + UNR * ph;
    if (!(MODE == 1 && sb_stop)) {
    f32x16 sq[UNR][2];
#pragma unroll
    for (int hf = 0; hf < UNR; ++hf) {
        const int i = i0 + hf;
        const int bi = DEEP ? (pp * 2 + hf) : (i & 1);
        const int t = ATT_TILE(i);
        if (DEEP) { if (hf == 0 && i0 + 4 < nkt) { ATT_LOADG(ATT_TILE(i0 + 4), (DEEP ? 2 * ph : 0)); ATT_LOADG(ATT_TILE(i0 + 5), (DEEP ? 2 * ph + 1 : 0)); } } else { if (i + 1 < nkt) ATT_LOADG(ATT_TILE(i + 1), 0); }
        if (t <= my_last && !(MODE == 1 && sb_done)) {
            const LAS unsigned char* kb = lds + bi * BUF + l32 * KST + hi * 16;
            f32x16& s0 = sq[hf][0]; f32x16& s1 = sq[hf][1];
            if (QKFIRST) {
            {
                const bf16x8 a0 = *(const LAS bf16x8*)(kb), a1 = *(const LAS bf16x8*)(kb + 32 * KST);
                if (MODE == 1) { const f32x16 z16 = {0.f, 0.f, 0.f, 0.f, 0.f, 0.f, 0.f, 0.f, 0.f, 0.f, 0.f, 0.f, 0.f, 0.f, 0.f, 0.f};
                    s0 = __builtin_amdgcn_mfma_f32_32x32x16_bf16(a0, qf[0], z16, 0, 0, 0); s1 = __builtin_amdgcn_mfma_f32_32x32x16_bf16(a1, qf[0], z16, 0, 0, 0); }
                else { s0 = __builtin_amdgcn_mfma_f32_32x32x16_bf16(a0, qf[0], negm, 0, 0, 0); s1 = __builtin_amdgcn_mfma_f32_32x32x16_bf16(a1, qf[0], negm, 0, 0, 0); }
            }
#pragma unroll
            for (int d0 = 1; d0 < ND0; ++d0) {
                const bf16x8 a0 = *(const LAS bf16x8*)(kb + d0 * 32), a1 = *(const LAS bf16x8*)(kb + 32 * KST + d0 * 32);
                s0 = __builtin_amdgcn_mfma_f32_32x32x16_bf16(a0, qf[d0], s0, 0, 0, 0);
                s1 = __builtin_amdgcn_mfma_f32_32x32x16_bf16(a1, qf[d0], s1, 0, 0, 0);
            }
            }
        }
    }
#pragma unroll
    for (int hf = 0; hf < UNR; ++hf) {
        const int i = i0 + hf;
        const int bi = DEEP ? (pp * 2 + hf) : (i & 1);
        const int t = ATT_TILE(i);
        if (t <= my_last && !(MODE == 1 && sb_done)) {
            const LAS unsigned char* vb = lds + bi * BUF + KBUF + l32 * VST + hi * 16;
            f32x16& s0 = sq[hf][0]; f32x16& s1 = sq[hf][1];
            if (!QKFIRST) {
                const LAS unsigned char* kb = lds + bi * BUF + l32 * KST + hi * 16;
            {
                const bf16x8 a0 = *(const LAS bf16x8*)(kb), a1 = *(const LAS bf16x8*)(kb + 32 * KST);
                if (MODE == 1) { const f32x16 z16 = {0.f, 0.f, 0.f, 0.f, 0.f, 0.f, 0.f, 0.f, 0.f, 0.f, 0.f, 0.f, 0.f, 0.f, 0.f, 0.f};
                    s0 = __builtin_amdgcn_mfma_f32_32x32x16_bf16(a0, qf[0], z16, 0, 0, 0); s1 = __builtin_amdgcn_mfma_f32_32x32x16_bf16(a1, qf[0], z16, 0, 0, 0); }
                else { s0 = __builtin_amdgcn_mfma_f32_32x32x16_bf16(a0, qf[0], negm, 0, 0, 0); s1 = __builtin_amdgcn_mfma_f32_32x32x16_bf16(a1, qf[0], negm, 0, 0, 0); }
            }
#pragma unroll
            for (int d0 = 1; d0 < ND0; ++d0) {
                const bf16x8 a0 = *(const LAS bf16x8*)(kb + d0 * 32), a1 = *(const LAS bf16x8*)(kb + 32 * KST + d0 * 32);
                s0 = __builtin_amdgcn_mfma_f32_32x32x16_bf16(a0, qf[d0], s0, 0, 0, 0);
                s1 = __builtin_amdgcn_mfma_f32_32x32x16_bf16(a1, qf[d0], s1, 0, 0, 0);
            }
            }
            bf16x8 vf[2][4];
#define ATT_LOADV(dst, db_) do { const LAS unsigned char* vr_ = vb + (db_) * 32 * VST; _Pragma("unroll") for (int kk = 0; kk < 4; ++kk) dst[kk] = *(const LAS bf16x8*)(vr_ + kk * 32); } while (0)
            ATT_LOADV(vf[0], 0); if (!DEEP) ATT_LOADV(vf[1], 1);
            __builtin_amdgcn_sched_barrier(0);
            if (MODE != 1) {
                float mx = fmaxf(s0[0], s1[0]);
#pragma unroll
                for (int r = 1; r < 16; ++r) mx = fmaxf(fmaxf(mx, s0[r]), s1[r]);
                { float a, b; swap32(mx, a, b); mx = fmaxf(a, b); }
                const bool first = (i == 0);
                if (first || __any(mx > 8.0f)) {
                    const float dl = first ? mx : fmaxf(mx, 0.f);
                    mhat += dl;
#pragma unroll
                    for (int r = 0; r < 16; ++r) { s0[r] -= dl; s1[r] -= dl; negm[r] = -mhat; }
                    if (DEEP && QKFIRST && hf == 0 && (ATT_TILE(i0 + UNR - 1) <= my_last)) {
#pragma unroll
                        for (int r = 0; r < 16; ++r) { sq[UNR - 1][0][r] -= dl; sq[UNR - 1][1][r] -= dl; }
                    }
                    if (!first) {
                        const float alpha = __builtin_amdgcn_exp2f(-dl);
#pragma unroll
                        for (int r = 0; r < 16; ++r) lacc[r] *= alpha;
#pragma unroll
                        for (int i2 = 0; i2 < NDB; ++i2)
#pragma unroll
                            for (int r = 0; r < 16; ++r) o[i2][r] *= alpha;
                    }
                }
#pragma unroll
                for (int r = 0; r < 16; ++r) { s0[r] = __builtin_amdgcn_exp2f(s0[r]); s1[r] = __builtin_amdgcn_exp2f(s1[r]); }
            } else {
                const bool diag = (t == my_last);
                const int qrel = q0 + wid * 32 + l32 - t * 64;
                float kp[32], gprod[8];
#pragma unroll
                for (int k = 0; k < 8; ++k) {
#pragma unroll
                    for (int e = 0; e < 4; ++e) {
                        const int r = (k & 3) * 4 + e;
                        const float z2 = __builtin_amdgcn_fmed3f((k < 4) ? s0[r] : s1[r], -126.0f, 126.0f);
                        const float E = __builtin_amdgcn_exp2f(z2);
                        const float keep = __builtin_amdgcn_rcpf(fadd_s(E, 1.0f)), beta = fmul_s(E, keep);
                        kp[k * 4 + e] = keep;
                        if (k < 4) s0[r] = beta; else s1[r] = beta;
                    }
                }
                if (diag) {
                    asm volatile("" ::: "memory");
#pragma unroll
                    for (int k = 0; k < 8; ++k)
#pragma unroll
                        for (int e = 0; e < 4; ++e) { const int r = (k & 3) * 4 + e; const int kl = (k >> 2) * 32 + e + 8 * (k & 3) + 4 * hi; const bool valid = kl < qrel;
                            kp[k * 4 + e] = valid ? kp[k * 4 + e] : 1.0f; if (k < 4) s0[r] = valid ? s0[r] : 0.f; else s1[r] = valid ? s1[r] : 0.f; }
                }
#pragma unroll
                for (int k = 0; k < 8; ++k) gprod[k] = fmul_s(fmul_s(kp[k * 4], kp[k * 4 + 1]), fmul_s(kp[k * 4 + 2], kp[k * 4 + 3]));
                float base[8]; float suf = 1.0f;
#pragma unroll
                for (int k = 7; k >= 0; --k) { float glo, ghi; swap32(gprod[k], glo, ghi); base[k] = fmul_s(fmul_s(Rp, suf), (hi == 0 ? ghi : 1.0f)); suf = fmul_s(suf, fmul_s(glo, ghi)); }
                Rp *= suf;
                { const bool nd = __all(Rp == 0.0f); if (nd && !sb_done && lane == 0) __hip_atomic_fetch_add(sbcnt, 1u, __ATOMIC_RELAXED, __HIP_MEMORY_SCOPE_WORKGROUP); sb_done = nd; }
#pragma unroll
                for (int k = 0; k < 8; ++k) {
                    const float l3 = base[k], l2 = fmul_s(l3, kp[k * 4 + 3]), l1 = fmul_s(l2, kp[k * 4 + 2]), l0 = fmul_s(l1, kp[k * 4 + 1]);
                    const int r = (k & 3) * 4;
                    if (k < 4) { s0[r] = fmul_s(s0[r], l0); s0[r + 1] = fmul_s(s0[r + 1], l1); s0[r + 2] = fmul_s(s0[r + 2], l2); s0[r + 3] = fmul_s(s0[r + 3], l3); }
                    else       { s1[r] = fmul_s(s1[r], l0); s1[r + 1] = fmul_s(s1[r + 1], l1); s1[r + 2] = fmul_s(s1[r + 2], l2); s1[r + 3] = fmul_s(s1[r + 3], l3); }
                }
            }
            bf16x8 pb[4];
#pragma unroll
            for (int kk = 0; kk < 4; ++kk) {
                u32x4 w;
                if (kk < 2) { const int b = kk * 8; w.x = cvtpk(s0[b], s0[b + 1]); w.y = cvtpk(s0[b + 2], s0[b + 3]); w.z = cvtpk(s0[b + 4], s0[b + 5]); w.w = cvtpk(s0[b + 6], s0[b + 7]); }
                else        { const int b = (kk - 2) * 8; w.x = cvtpk(s1[b], s1[b + 1]); w.y = cvtpk(s1[b + 2], s1[b + 3]); w.z = cvtpk(s1[b + 4], s1[b + 5]); w.w = cvtpk(s1[b + 6], s1[b + 7]); }
                pb[kk] = __builtin_bit_cast(bf16x8, w);
            }
            __builtin_amdgcn_sched_barrier(0);
            if (MODE != 1) { const bf16x8 ones = {16256, 16256, 16256, 16256, 16256, 16256, 16256, 16256};
#pragma unroll
                for (int kk = 0; kk < 4; ++kk) lacc = __builtin_amdgcn_mfma_f32_32x32x16_bf16(ones, pb[kk], lacc, 0, 0, 0); }
#pragma unroll
            for (int dbp = 0; dbp < NDB; dbp += 2) {
#pragma unroll
                for (int kk = 0; kk < 4; ++kk) o[dbp] = __builtin_amdgcn_mfma_f32_32x32x16_bf16(vf[0][kk], pb[kk], o[dbp], 0, 0, 0);
                if (DEEP) ATT_LOADV(vf[0], dbp + 1);
#pragma unroll
                for (int kk = 0; kk < 4; ++kk) o[dbp + 1] = __builtin_amdgcn_mfma_f32_32x32x16_bf16(vf[DEEP ? 0 : 1][kk], pb[kk], o[dbp + 1], 0, 0, 0);
                if (dbp + 2 < NDB) { ATT_LOADV(vf[0], dbp + 2); ATT_LOADV(vf[1], dbp + 3); }
            }
#undef ATT_LOADV
        }
        if (DEEP) { if (hf == 1) { if (i0 + 2 < nkt) { ATT_STORE((pp ^ 1) * 2, (DEEP ? 2 * (ph ^ 1) : 0)); ATT_STORE((pp ^ 1) * 2 + 1, (DEEP ? 2 * (ph ^ 1) + 1 : 0)); } ATT_BAR(); pp ^= 1;
            if (MODE == 1) { sb_stop = (__builtin_amdgcn_readfirstlane((int)*(volatile LAS unsigned*)sbcnt) >= 8); ATT_BAR(); } } }
        else { if (i + 1 < nkt) ATT_STORE(bi ^ 1, 0); ATT_BAR(); }
    }
    }
    }
    }
    float inv = 1.0f;
    if (MODE != 1) inv = 1.0f / lacc[0];
    if (DIFF && mp == 0) {
#pragma unroll
        for (int db = 0; db < NDB; ++db)
#pragma unroll
            for (int g = 0; g < 8; ++g) o1l[(db * 8 + g) * 64] = cvtpk(o[db][2 * g] * inv, o[db][2 * g + 1] * inv);
        continue;
    }
    bf16_t* orow = O + (size_t)(q0 + wid * 32 + l32) * ldo + 4 * hi;
    if (DIFF) {
        float s = 0.f;
#pragma unroll
        for (int db = 0; db < NDB; ++db)
#pragma unroll
            for (int g = 0; g < 8; ++g) { const unsigned w = o1l[(db * 8 + g) * 64];
                const float a = bflo(w) - lam * (o[db][2 * g] * inv), b = bfhi(w) - lam * (o[db][2 * g + 1] * inv);
                o[db][2 * g] = a; o[db][2 * g + 1] = b; s += a * a + b * b; if (g == 7) asm volatile("" ::: "memory"); }
        { float a, b; swap32(s, a, b); s = a + b; }
        const float rs = post / sqrtf(s * (1.0f / DV) + EPS);
#pragma unroll
        for (int db = 0; db < NDB; ++db)
#pragma unroll
            for (int g = 0; g < 4; ++g) { const f32x4 gn = *(const f32x4*)(subln + db * 32 + 8 * g + 4 * hi);
                u32x2 w; w.x = cvtpk(o[db][4 * g] * rs * gn[0], o[db][4 * g + 1] * rs * gn[1]); w.y = cvtpk(o[db][4 * g + 2] * rs * gn[2], o[db][4 * g + 3] * rs * gn[3]);
                *(u32x2*)(orow + db * 32 + 8 * g) = w; }
    } else {
#pragma unroll
        for (int db = 0; db < NDB; ++db)
#pragma unroll
            for (int g = 0; g < 4; ++g) {
                u32x2 w; w.x = cvtpk(o[db][4 * g] * inv, o[db][4 * g + 1] * inv); w.y = cvtpk(o[db][4 * g + 2] * inv, o[db][4 * g + 3] * inv);
                *(u32x2*)(orow + db * 32 + 8 * g) = w;
            }
    }
    }
#undef ATT_TILE
#undef ATT_LOADG
#undef ATT_STORE
#undef ATT_BAR
}

constexpr size_t MiB = 1u << 20;
constexpr int SSQ_MQ = 8, SSQ_MKV = 9, SSQ_MEM = 10, NSSQ = 11;
constexpr size_t WS_BAR = 1792 * 1024, BAR_BYTES = 16384;
constexpr size_t WS_KMEM = 2 * MiB;
constexpr size_t WS_VTMEM = 6 * MiB;
constexpr size_t WS_MEMB = 10 * MiB;
constexpr size_t WS_W = 16 * MiB;
constexpr size_t SZ_WGU = (size_t)2 * DFF * DM * 2, SZ_WD = (size_t)DM * DFF * 2, SZ_FFN = SZ_WGU + SZ_WD;
constexpr size_t WS_FFN = WS_W;
constexpr size_t WS_WQK0 = WS_FFN + 4 * SZ_FFN;
constexpr size_t WS_WV0 = WS_WQK0 + 4 * MiB;
constexpr size_t WS_WOUT0 = WS_WV0 + 2 * MiB;
constexpr size_t WS_WD1 = WS_WOUT0 + 2 * MiB;
constexpr size_t WS_WUQ = WS_WD1 + 2 * MiB;
constexpr size_t WS_WUKVK = WS_WUQ + 3 * MiB / 2;
constexpr size_t WS_WUKVV = WS_WUKVK + MiB / 2;
constexpr size_t WS_WO1 = WS_WUKVV + MiB / 2;
constexpr size_t WS_XM = WS_WO1 + 2 * MiB;
constexpr size_t WS_XB = 105 * MiB;
static_assert(WS_XM + 8 * MiB <= WS_XB, "weights");
constexpr size_t WS_R1 = 170 * MiB;
constexpr size_t WS_H = WS_R1;
constexpr size_t WS_QK0 = WS_R1;
constexpr size_t WS_VT0 = WS_R1 + 128 * MiB;
constexpr size_t WS_OD0 = WS_R1 + 192 * MiB;
constexpr size_t WS_MIX0 = WS_R1 + 256 * MiB;
constexpr size_t WS_T1 = WS_R1;
constexpr size_t WS_Q1 = WS_R1 + 64 * MiB;
constexpr size_t WS_K1 = WS_R1 + 160 * MiB;
constexpr size_t WS_VT1 = WS_R1 + 256 * MiB;
constexpr size_t WS_O1 = WS_R1;
constexpr size_t WS_XQ = WS_R1;
constexpr size_t WS_XO = WS_R1 + 32 * MiB;
constexpr size_t WS_SSQ = WS_R1 + 320 * MiB;
constexpr size_t WS_END = WS_SSQ + (size_t)NSSQ * MTOK * 16 * 4;
static_assert(WS_END <= 512 * MiB && WS_XB + (size_t)MTOK * DM * 2 <= WS_R1, "ws map");

struct Params { const float* in[32]; float* out; unsigned char* ws; int lo, hi; };

__device__ __forceinline__ float wave_sum(float v) {
#pragma unroll
    for (int o = 1; o < 64; o <<= 1) v += __shfl_xor(v, o);
    return v;
}
__device__ __forceinline__ void prep_decode(int it, int nblk, int mode, bf16_t* d0, bf16_t* d1, int& k0, int& j0, bf16_t*& dst, int& row0) {
    const int kb = it / nblk, nb = it % nblk; k0 = 64 * kb; j0 = 32 * nb;
    dst = d0; row0 = j0;
    switch (mode) {
        case 1: row0 = (j0 >> 7) * 256 + (j0 & 127); break;
        case 2: row0 = (j0 >> 7) * 256 + 128 + (j0 & 127); break;
        case 3: { const int seg = j0 >> 9, r = j0 & 511; if (seg <= 1) { const int hd = j0 >> 6, dd = j0 & 63; row0 = (hd >> 2) * 256 + (dd >> 5) * 128 + (hd & 3) * 32; } else if (seg == 2) { dst = d1; row0 = r; } else if (seg == 3) row0 = 1024 + r; else if (seg == 4) row0 = 1536 + r; else { dst = d1; row0 = 512 + r; } } break;
        case 4: { const int h = j0 >> 7, w = j0 & 127; if (w < 64) row0 = (h >> 2) * 256 + (w >> 5) * 128 + (h & 3) * 32; else { dst = d1; row0 = h * 64 + w - 64; } } break;
        case 5: if (j0 >= 512) { dst = d1; row0 = j0 - 512; } break;
        case 6: row0 = 512 + j0; break;
        default: break;
    }
}
__device__ __forceinline__ void prep_job(const float* __restrict__ W, int Ns, int K, const float* __restrict__ gain, int mode, bf16_t* d0, bf16_t* d1,
                                         LAS float* scr, int gw, int NGW, int lane) {
    const int nblk = Ns / 32, nitems = (K / 64) * nblk;
    const int lr = lane >> 3, lc = (lane & 7) * 4;
    f32x4 ld[8]; float gg[8];
    int it = gw;
#define PREP_LOAD(it_) do { int k0_, j0_, r0_; bf16_t* ds_; prep_decode((it_), nblk, mode, d0, d1, k0_, j0_, ds_, r0_); \
        _Pragma("unroll") for (int i = 0; i < 8; ++i) { const int kk = i * 8 + lr; ld[i] = *(const f32x4*)(W + (size_t)(k0_ + kk) * Ns + j0_ + lc); gg[i] = gain ? gain[k0_ + kk] : 1.0f; } } while (0)
    if (it < nitems) PREP_LOAD(it);
    while (it < nitems) {
        int k0, j0, row0; bf16_t* dst; prep_decode(it, nblk, mode, d0, d1, k0, j0, dst, row0);
#pragma unroll
        for (int i = 0; i < 8; ++i) { const int kk = i * 8 + lr;
#pragma unroll
            for (int e = 0; e < 4; ++e) scr[kk * 33 + lc + e] = ld[i][e] * gg[i]; }
        const int itn = it + NGW;
        if (itn < nitems) PREP_LOAD(itn);
        asm volatile("s_waitcnt lgkmcnt(0)" ::: "memory");
        const int cch = lane & 7;
#pragma unroll
        for (int j = 0; j < 4; ++j) { const int n = (lane >> 3) + 8 * j; const LAS float* s = scr + (8 * cch) * 33 + n;
            u32x4 o; o.x = cvtpk(s[0 * 33], s[1 * 33]); o.y = cvtpk(s[2 * 33], s[3 * 33]); o.z = cvtpk(s[4 * 33], s[5 * 33]); o.w = cvtpk(s[6 * 33], s[7 * 33]);
            *(u32x4*)(dst + (size_t)(row0 + n) * K + k0 + 8 * cch) = o; }
        asm volatile("s_waitcnt lgkmcnt(0)" ::: "memory");
        it = itn;
    }
#undef PREP_LOAD
}
constexpr int PT_W = 0, PT_G = 256, PT_D0 = 512, PT_D1 = 768, PT_NS = 1024, PT_K = 1152, PT_MODE = 1280, PT_START = 1408;
__device__ __forceinline__ int rfl(int v) { return __builtin_amdgcn_readfirstlane(v); }
__device__ __forceinline__ unsigned long long rfl64(unsigned long long v) { return ((unsigned long long)(unsigned)rfl((int)(v >> 32)) << 32) | (unsigned)rfl((int)(unsigned)v); }
__device__ __forceinline__ void prep_addjob(LAS unsigned char* tb, int& nj, int& acc, const float* W, int Ns, int K, const float* gain, int mode, bf16_t* d0, bf16_t* d1) {
    ((LAS unsigned long long*)(tb + PT_W))[nj] = (unsigned long long)W; ((LAS unsigned long long*)(tb + PT_G))[nj] = (unsigned long long)gain;
    ((LAS unsigned long long*)(tb + PT_D0))[nj] = (unsigned long long)d0; ((LAS unsigned long long*)(tb + PT_D1))[nj] = (unsigned long long)d1;
    ((LAS int*)(tb + PT_NS))[nj] = Ns; ((LAS int*)(tb + PT_K))[nj] = K; ((LAS int*)(tb + PT_MODE))[nj] = mode; ((LAS int*)(tb + PT_START))[nj] = acc;
    acc += (K / 64) * (Ns / 32); ++nj; ((LAS int*)(tb + PT_START))[nj] = acc;
}
__device__ __forceinline__ void prep_all(LAS unsigned char* tb, int njobs, LAS float* scr, int gw, int NGW, int lane) {
    LAS int* tStart = (LAS int*)(tb + PT_START);
    const int total = rfl(tStart[njobs]);
    const int lr = lane >> 3, lc = (lane & 7) * 4;
    f32x4 ld[8]; float gg[8];
    int j = 0, k0n = 0, row0n = 0, Kn = 0; bf16_t* dstn = nullptr;
#define PREP_LOAD(it_) do { while ((it_) >= rfl(tStart[j + 1])) ++j; \
        const int loc_ = (it_) - rfl(tStart[j]); const int Ns_ = rfl(((LAS int*)(tb + PT_NS))[j]); Kn = rfl(((LAS int*)(tb + PT_K))[j]); const int mode_ = rfl(((LAS int*)(tb + PT_MODE))[j]); \
        const float* W_ = (const float*)rfl64(((LAS unsigned long long*)(tb + PT_W))[j]); const float* g_ = (const float*)rfl64(((LAS unsigned long long*)(tb + PT_G))[j]); \
        bf16_t* d0_ = (bf16_t*)rfl64(((LAS unsigned long long*)(tb + PT_D0))[j]); bf16_t* d1_ = (bf16_t*)rfl64(((LAS unsigned long long*)(tb + PT_D1))[j]); \
        int j0_; prep_decode(loc_, Ns_ / 32, mode_, d0_, d1_, k0n, j0_, dstn, row0n); \
        _Pragma("unroll") for (int i = 0; i < 8; ++i) { const int kk = i * 8 + lr; ld[i] = *(const f32x4*)(W_ + (size_t)(k0n + kk) * Ns_ + j0_ + lc); gg[i] = g_ ? g_[k0n + kk] : 1.0f; } } while (0)
    int it = gw;
    if (it < total) PREP_LOAD(it);
    while (it < total) {
        const int k0 = k0n, row0 = row0n, K = Kn; bf16_t* dst = dstn;
#pragma unroll
        for (int i = 0; i < 8; ++i) { const int kk = i * 8 + lr;
#pragma unroll
            for (int e = 0; e < 4; ++e) scr[kk * 33 + lc + e] = ld[i][e] * gg[i]; }
        const int itn = it + NGW;
        if (itn < total) PREP_LOAD(itn);
        asm volatile("s_waitcnt lgkmcnt(0)" ::: "memory");
        const int cch = lane & 7;
#pragma unroll
        for (int jj = 0; jj < 4; ++jj) { const int n = (lane >> 3) + 8 * jj; const LAS float* sp = scr + (8 * cch) * 33 + n;
            u32x4 o; o.x = cvtpk(sp[0 * 33], sp[1 * 33]); o.y = cvtpk(sp[2 * 33], sp[3 * 33]); o.z = cvtpk(sp[4 * 33], sp[5 * 33]); o.w = cvtpk(sp[6 * 33], sp[7 * 33]);
            *(u32x4*)(dst + (size_t)(row0 + n) * K + k0 + 8 * cch) = o; }
        asm volatile("s_waitcnt lgkmcnt(0)" ::: "memory");
        it = itn;
    }
#undef PREP_LOAD
}
__device__ __forceinline__ void row_to_bf16(const float* xrow, bf16_t* orow, float* ssq, int lane) {
    const f32x4* xr = (const f32x4*)xrow + lane; float s = 0.f;
    unsigned long long* o8 = (unsigned long long*)orow + lane;
#pragma unroll
    for (int j = 0; j < 4; ++j) { const f32x4 v = xr[64 * j]; s += (v[0] * v[0] + v[1] * v[1]) + (v[2] * v[2] + v[3] * v[3]);
        o8[64 * j] = (unsigned long long)cvtpk(v[0], v[1]) | ((unsigned long long)cvtpk(v[2], v[3]) << 32); }
    s = wave_sum(s);
    if (lane < 16) ssq[lane] = (lane == 0) ? s : 0.f;
}

__device__ __forceinline__ void ld8(const bf16_t* p, float (&v)[8]) { const u32x4 w = *(const u32x4*)p; v[0] = bflo(w.x); v[1] = bfhi(w.x); v[2] = bflo(w.y); v[3] = bfhi(w.y); v[4] = bflo(w.z); v[5] = bfhi(w.z); v[6] = bflo(w.w); v[7] = bfhi(w.w); }
__device__ __forceinline__ void st8(bf16_t* p, const float (&v)[8]) { u32x4 w; w.x = cvtpk(v[0], v[1]); w.y = cvtpk(v[2], v[3]); w.z = cvtpk(v[4], v[5]); w.w = cvtpk(v[6], v[7]); *(u32x4*)p = w; }

__device__ __forceinline__ void pp_l0(bf16_t* QK, const float* gq, const float* gk, int gw, int NGW, int lane) {
    const int sub = lane >> 3, j = lane & 7;
    for (int it = gw; it < MTOK * 2; it += NGW) {
        const int tok = it >> 1, hv = (it & 1) * 8 + sub;
        bf16_t* p = QK + (size_t)tok * 2048 + hv * 64 + j * 8;
        float v[8]; ld8(p, v);
        float s = 0.f;
#pragma unroll
        for (int e = 0; e < 8; ++e) s += v[e] * v[e];
        s += __shfl_xor(s, 1); s += __shfl_xor(s, 2); s += __shfl_xor(s, 4);
        const float rs = 1.0f / sqrtf(s * (1.0f / 64.0f) + EPS);
        const float* g = (hv < 8 ? gq : gk) + j * 8;
#pragma unroll
        for (int e = 0; e < 8; ++e) v[e] = v[e] * rs * g[e];
        const int pos = tok & (SEQ - 1);
        float o[8];
#pragma unroll
        for (int e = 0; e < 8; ++e) {
            const float pv = __shfl_xor(v[e], 4);
            float cs, sn; rope_cs(pos, (j & 3) * 8 + e, cs, sn);
            o[e] = (j < 4) ? (v[e] * cs - pv * sn) : (pv * sn + v[e] * cs);
        }
        st8(p, o);
    }
}
__device__ __forceinline__ void pp_norm128(bf16_t* X, int nvec, const float* g, int gw, int NGW, int lane) {
    const int sub = lane >> 4, j = lane & 15;
    for (int it = gw; it < nvec / 4; it += NGW) {
        bf16_t* p = X + (size_t)(it * 4 + sub) * 128 + j * 8;
        float v[8]; ld8(p, v);
        float s = 0.f;
#pragma unroll
        for (int e = 0; e < 8; ++e) s += v[e] * v[e];
        s += __shfl_xor(s, 1); s += __shfl_xor(s, 2); s += __shfl_xor(s, 4); s += __shfl_xor(s, 8);
        const float rs = 1.0f / sqrtf(s * (1.0f / 128.0f) + EPS);
#pragma unroll
        for (int e = 0; e < 8; ++e) v[e] = v[e] * rs * g[j * 8 + e];
        st8(p, v);
    }
}
__device__ __forceinline__ void pp_combine(const bf16_t* OD, bf16_t* MIX, const float* subln, float lam, float post, int gw, int NGW, int lane) {
    const int sub = lane >> 4, j = lane & 15;
    for (int it = gw; it < MTOK; it += NGW) {
        const bf16_t* p1 = OD + (size_t)it * 1024 + sub * 128 + j * 8;
        float a[8], b[8]; ld8(p1, a); ld8(p1 + 512, b);
        float s = 0.f;
#pragma unroll
        for (int e = 0; e < 8; ++e) { a[e] = a[e] - lam * b[e]; s += a[e] * a[e]; }
        s += __shfl_xor(s, 1); s += __shfl_xor(s, 2); s += __shfl_xor(s, 4); s += __shfl_xor(s, 8);
        const float rs = post / sqrtf(s * (1.0f / 128.0f) + EPS);
#pragma unroll
        for (int e = 0; e < 8; ++e) a[e] = a[e] * rs * subln[j * 8 + e];
        st8(MIX + (size_t)it * 1024 + sub * 128 + j * 8, a);
    }
}
__device__ __forceinline__ void pp_mla(bf16_t* X  , const bf16_t* T1, const float* g, bool isk, int gw, int NGW, int lane) {
    const int sub = lane >> 4, j = lane & 15;
    for (int it = gw; it < MTOK * 4; it += NGW) {
        const int tok = it >> 2, h = (it & 3) * 4 + sub;
        bf16_t* p = X + (size_t)tok * 1536 + h * 96 + j * 8;
        float v[8];
#pragma unroll
        for (int e = 0; e < 8; ++e) v[e] = 0.f;
        if (j < 12) { if (isk && j >= 8) ld8(T1 + (size_t)tok * 1024 + 768 + (j - 8) * 8, v); else ld8(p, v); }
        float s = 0.f;
#pragma unroll
        for (int e = 0; e < 8; ++e) s += v[e] * v[e];
        s += __shfl_xor(s, 1); s += __shfl_xor(s, 2); s += __shfl_xor(s, 4); s += __shfl_xor(s, 8);
        const float rs = 1.0f / sqrtf(s * (1.0f / 96.0f) + EPS);
        const int jj = j < 12 ? j : 0;
#pragma unroll
        for (int e = 0; e < 8; ++e) v[e] = v[e] * rs * g[jj * 8 + e];
        const int pos = tok & (SEQ - 1);
        float o[8];
#pragma unroll
        for (int e = 0; e < 8; ++e) {
            const float pv = __shfl_xor(v[e], 2);
            o[e] = v[e];
            if (j >= 8) { float cs, sn; rope_cs(pos, 2 * ((j & 1) * 8 + e), cs, sn); o[e] = (j < 10) ? (v[e] * cs - pv * sn) : (pv * sn + v[e] * cs); }
        }
        if (j < 12) st8(p, o);
    }
}


#define XB_TMO      128
#define XB_XCNT(j)  (256  + 64 * (j))
#define XB_XSUB(j)  (1280 + 64 * (j))
#define XB_XGEN(j)  (2304 + 64 * (j))
#define XB_TOP      3328
#define XB_TOPGEN   3392
#define XCD_BAR_WORDS 3456
#define XB_SPIN_CAP (1u << 18)
__device__ __forceinline__ unsigned xb_ld(unsigned* p)              { return __hip_atomic_load(p, __ATOMIC_RELAXED, __HIP_MEMORY_SCOPE_AGENT); }
__device__ __forceinline__ unsigned xb_add(unsigned* p, unsigned v) { return __hip_atomic_fetch_add(p, v, __ATOMIC_RELAXED, __HIP_MEMORY_SCOPE_AGENT); }
__device__ __forceinline__ unsigned xb_xcc_id() { return (unsigned)__builtin_amdgcn_s_getreg((3 << 11) | 20) & 0xFu; }
#define XB_SPIN(cond, bar) do { unsigned _sp = 0; while (cond) { __builtin_amdgcn_s_sleep(1); \
    if ((++_sp & 255u) == 0u) { if (xb_ld(&(bar)[XB_TMO])) break; if (_sp > XB_SPIN_CAP) { atomicAdd(&(bar)[XB_TMO], 1u); break; } } } } while (0)
struct XcdBarrier { unsigned* bar; unsigned x; volatile LAS unsigned* st; int wave; };
__device__ __forceinline__ XcdBarrier xcd_barrier_post(unsigned* bar, volatile LAS unsigned* st, int wave_s) {
    XcdBarrier b; b.bar = bar; b.x = xb_xcc_id(); b.st = st; b.wave = wave_s;
    if (wave_s == 0 && lane_now() == 0) (void)xb_add(&bar[XB_XCNT(b.x)], 1u);
    return b;
}
__device__ __forceinline__ void xcd_barrier_complete(unsigned* bar, unsigned x, unsigned& nloc, unsigned& nx) {
    const unsigned G = gridDim.x * gridDim.y * gridDim.z;
    unsigned sum, cnt, mine, sp = 0u;
    for (;;) {
        sum = 0u; cnt = 0u; mine = 0u;
#pragma unroll
        for (unsigned j = 0; j < 16; ++j) { const unsigned c = xb_ld(&bar[XB_XCNT(j)]); sum += c; cnt += (c > 0u) ? 1u : 0u; mine = (j == x) ? c : mine; }
        if (sum == G) break;
        __builtin_amdgcn_s_sleep(1);
        if ((++sp & 255u) == 0u) { if (xb_ld(&bar[XB_TMO])) break; if (sp > XB_SPIN_CAP) { atomicAdd(&bar[XB_TMO], 1u); break; } }
    }
    nloc = mine > 0u ? mine : 1u; nx = cnt > 0u ? cnt : 1u;
}
__device__ __forceinline__ void xcd_barrier(const XcdBarrier& b) {
    asm volatile("s_waitcnt vmcnt(0)" ::: "memory");
    __syncthreads();
    if (b.wave == 0 && lane_now() == 0) {
        unsigned* bar = b.bar;
        __builtin_amdgcn_s_waitcnt(0);
        unsigned nloc = b.st[0], nx = b.st[1];
        if (nloc == 0u) { xcd_barrier_complete(bar, b.x, nloc, nx); b.st[0] = nloc; b.st[1] = nx; }
        const unsigned old = xb_add(&bar[XB_XSUB(b.x)], 1u);
        const unsigned gen = old / nloc;
        if (old + 1u == (gen + 1u) * nloc) {
            __builtin_amdgcn_fence(__ATOMIC_RELEASE, "agent");
            asm volatile("s_waitcnt vmcnt(0)" ::: "memory");
            const unsigned og = xb_add(&bar[XB_TOP], 1u);
            const unsigned tg = og / nx;
            if (og + 1u == (tg + 1u) * nx) xb_add(&bar[XB_TOPGEN], 1u);
            else XB_SPIN(xb_ld(&bar[XB_TOPGEN]) == tg, bar);
            __builtin_amdgcn_fence(__ATOMIC_ACQUIRE, "agent");
            xb_add(&bar[XB_XGEN(b.x)], 1u);
            asm volatile("s_waitcnt vmcnt(0)" ::: "memory");
        } else {
            XB_SPIN(xb_ld(&bar[XB_XGEN(b.x)]) == gen, bar);
            __builtin_amdgcn_fence(__ATOMIC_ACQUIRE, "agent");
            asm volatile("s_waitcnt vmcnt(0)" ::: "memory");
        }
    }
    __syncthreads();
}

#ifndef REP_ATT
#define REP_ATT 1
#endif
#ifndef REP_G1
#define REP_G1 1
#endif
#ifndef EXTRA_SYNC
#define EXTRA_SYNC 0
#endif
constexpr int LDS_BYTES = 135168;
__global__ void __launch_bounds__(512, 2) fwd_kernel(Params P) {
    extern __shared__ __attribute__((aligned(16))) unsigned char lds_raw[];
    LAS unsigned char* lds = (LAS unsigned char*)lds_raw;
    cg::grid_group grid = cg::this_grid();
    const int G = gridDim.x, bid = blockIdx.x, NGW = G * 8;
    float* xout = P.out;
    int ph = 0;
    const int wave_s = __builtin_amdgcn_readfirstlane((int)(threadIdx.x >> 6));
    if (threadIdx.x < 4) ((LAS unsigned*)(lds + 131072))[threadIdx.x] = 0u;
    __syncthreads();
    XcdBarrier bar = xcd_barrier_post((unsigned*)(P.ws + WS_BAR), (volatile LAS unsigned*)(lds + 131072), wave_s);
    if (P.lo < 0) grid.sync();
#define SSQ(i) (ssq + (size_t)(i) * MTOK * 16)
#define IN(k) P.in[(k) + z_]
#define PHASE_BEGIN if (ph >= P.lo && ph < P.hi) { const int tid = wave_s * 64 + lane_now(); int z_; asm volatile("s_mov_b32 %0, 0" : "=s"(z_)); \
    const int lane = tid & 63, wave = wave_s, gw = bid * 8 + wave; unsigned char* ws = P.ws + z_; float* ssq = (float*)(ws + WS_SSQ); \
    bf16_t* xb = (bf16_t*)(ws + WS_XB); bf16_t* memb = (bf16_t*)(ws + WS_MEMB); (void)lane; (void)gw; (void)memb; (void)xb; (void)ssq;
#define PHASE_END   } if (ph >= P.lo && ph + 1 < P.hi) { xcd_barrier(bar); for (int es_ = 0; es_ < EXTRA_SYNC; ++es_) xcd_barrier(bar); } ++ph;

    PHASE_BEGIN
    {
        LAS float* scr = (LAS float*)(lds + wave * 16384);
        for (size_t i = (size_t)bid * 512 + tid; i < (size_t)2 * MTOK * 16; i += (size_t)G * 512) SSQ(SSQ_MQ)[i] = 0.f;
        LAS unsigned char* tb = lds + 131072 + 64;
        if (wave == 0 && lane == 0) {
            int nj = 0, acc = 0;
            for (int l = 0; l < 2; ++l)
                for (int j = 0; j < 2; ++j) {
                    const int f = l * 2 + j;
                    bf16_t* wgu = (bf16_t*)(ws + WS_FFN + f * SZ_FFN); bf16_t* wd = (bf16_t*)(ws + WS_FFN + f * SZ_FFN + SZ_WGU);
                    const float* gn = IN(2) + (size_t)f * DM;
                    prep_addjob(tb, nj, acc, IN(3) + (size_t)f * DM * DFF, DFF, DM, gn, 1, wgu, nullptr);
                    prep_addjob(tb, nj, acc, IN(4) + (size_t)f * DM * DFF, DFF, DM, gn, 2, wgu, nullptr);
                    prep_addjob(tb, nj, acc, IN(5) + (size_t)f * DFF * DM, DM, DFF, nullptr, 0, wd, nullptr);
                }
            prep_addjob(tb, nj, acc, IN(7), 3072, DM, IN(6), 3, (bf16_t*)(ws + WS_WQK0), (bf16_t*)(ws + WS_WV0));
            prep_addjob(tb, nj, acc, IN(8), DM, DM, nullptr, 0, (bf16_t*)(ws + WS_WOUT0), nullptr);
            prep_addjob(tb, nj, acc, IN(16), 512, DM, IN(6) + DM, 0, (bf16_t*)(ws + WS_WD1), nullptr);
            prep_addjob(tb, nj, acc, IN(19), 288, DM, IN(6) + DM, 6, (bf16_t*)(ws + WS_WD1), nullptr);
            prep_addjob(tb, nj, acc, IN(18), 1536, 512, IN(17), 0, (bf16_t*)(ws + WS_WUQ), nullptr);
            prep_addjob(tb, nj, acc, IN(21), 2048, 256, IN(20), 4, (bf16_t*)(ws + WS_WUKVK), (bf16_t*)(ws + WS_WUKVV));
            prep_addjob(tb, nj, acc, IN(24), DM, DM, nullptr, 0, (bf16_t*)(ws + WS_WO1), nullptr);
            for (int l = 0; l < 2; ++l) {
                bf16_t* base = (bf16_t*)(ws + WS_XM + l * 4 * MiB);
                prep_addjob(tb, nj, acc, IN(27) + (size_t)l * DM * 512, 512, DM, IN(25) + l * DM, 0, base, nullptr);
                prep_addjob(tb, nj, acc, IN(28) + (size_t)l * DM * 1024, 1024, DM, IN(26) + l * DM, 5, base + 512 * 1024, base + 2 * 512 * 1024);
                prep_addjob(tb, nj, acc, IN(31) + (size_t)l * 512 * DM, DM, 512, nullptr, 0, base + 3 * 512 * 1024, nullptr);
            }
        }
        __syncthreads();
        prep_all(tb, 25, scr, gw, NGW, lane);
        for (int m = gw; m < MTOK; m += 4 * NGW) {
            f32x4 v[4][4];
#pragma unroll
            for (int q = 0; q < 4; ++q)
#pragma unroll
                for (int j = 0; j < 4; ++j) v[q][j] = ((const f32x4*)(IN(0) + (size_t)(m + q * NGW) * DM))[lane + 64 * j];
#pragma unroll
            for (int q = 0; q < 4; ++q) { float sq = 0.f; unsigned long long* o8 = (unsigned long long*)(xb + (size_t)(m + q * NGW) * DM) + lane;
#pragma unroll
                for (int j = 0; j < 4; ++j) { const f32x4 w = v[q][j]; sq += (w[0] * w[0] + w[1] * w[1]) + (w[2] * w[2] + w[3] * w[3]);
                    o8[64 * j] = (unsigned long long)cvtpk(w[0], w[1]) | ((unsigned long long)cvtpk(w[2], w[3]) << 32); }
                sq = wave_sum(sq); if (lane < 16) SSQ(0)[(size_t)(m + q * NGW) * 16 + lane] = (lane == 0) ? sq : 0.f; }
        }
        for (int m = gw; m < MMEM; m += NGW) row_to_bf16(IN(1) + (size_t)m * DM, memb + (size_t)m * DM, SSQ(SSQ_MEM) + (size_t)m * 16, lane);
    }
    PHASE_END

#define RUN_GEMM(EPI_T, epi, Aptr, lda_, Bptr, ldb_, M_, N_, K_) do { pg8::Gemm g_{(const bf16_t*)(Aptr), (const bf16_t*)(Bptr), (M_), (N_), (K_), (lda_), (ldb_)}; \
        pg8::StaticOrder S_; S_.init((M_), (N_), G, bid); pg8::gemm_phase<EPI_T>(lds, g_, S_, epi, wave_s); } while (0)
#define SNAKE(r_) ((r_) * G + (((r_) & 1) ? (G - 1 - bid) : bid))

    int nssq = 0;
    const float* xcur = P.in[0];
    { constexpr int layer = 0, half = 0;
            if constexpr (half == 1) {
                if constexpr (layer == 0) {
                    PHASE_BEGIN
                    { pg8::EpiQK0 e{(bf16_t*)(ws + WS_QK0), SSQ(nssq), IN(9), IN(10), 0.125f * LOG2E};
                      RUN_GEMM(pg8::EpiQK0, e, xb, DM, ws + WS_WQK0, DM, MTOK, 2048, DM);
                      pg8::EpiOutT et{(bf16_t*)(ws + WS_VT0), MTOK, SSQ(nssq), 1.0f / DM};
                      RUN_GEMM(pg8::EpiOutT, et, ws + WS_WV0, DM, xb, DM, 1024, MTOK, DM); }
                    PHASE_END
                    PHASE_BEGIN
                    { const bf16_t* QK = (const bf16_t*)(ws + WS_QK0); const bf16_t* VT = (const bf16_t*)(ws + WS_VT0);
                      float la = IN(11)[lane] * IN(12)[lane], lb2 = IN(13)[lane] * IN(14)[lane];
                      la = wave_sum(la); lb2 = wave_sum(lb2);
                      const float lam = expf(la) - expf(lb2) + 0.2f;
                      for (int rep = 0; rep < REP_ATT; ++rep) for (int r = 0;; ++r) { const int u = SNAKE(r); if (u >= 512) break;
                          const int qb = 15 - (u >> 5), bh = u & 31, b = bh >> 2, h = bh & 3;
                          attn_unit<64, 128, 0, 0, true>(lds, QK + (size_t)b * SEQ * 2048 + h * 64, 2048, QK + (size_t)b * SEQ * 2048 + 512 + h * 64, 2048,
                                                VT + (size_t)(h * 128) * MTOK + (size_t)b * SEQ, MTOK, (bf16_t*)(ws + WS_MIX0) + (size_t)b * SEQ * 1024 + h * 128, 1024,
                                                qb * 256, qb * 4 + 4, 0.125f * LOG2E, nullptr, IN(15), lam, 0.8f, wave_s); }
                      for (int rep = 0; rep < REP_ATT; ++rep) for (int r = 0;; ++r) { const int u = SNAKE(r); if (u >= 1024) break;
                          const int qb = 15 - (u >> 6), bh = u & 63, b = bh >> 3, h = bh & 7;
                          attn_unit<64, 64, 1, 0, false>(lds, QK + (size_t)b * SEQ * 2048 + 1024 + h * 64, 2048, QK + (size_t)b * SEQ * 2048 + 1536 + h * 64, 2048,
                                               VT + (size_t)(512 + h * 64) * MTOK + (size_t)b * SEQ, MTOK, (bf16_t*)(ws + WS_MIX0) + (size_t)b * SEQ * 1024 + 512 + h * 64, 1024,
                                               qb * 256, qb * 4 + 4, 0.125f * LOG2E, nullptr, nullptr, 0.f, 0.f, wave_s); } }
                    PHASE_END
                    PHASE_BEGIN
                    { pg8::EpiResidB<1> e{nullptr, nullptr, xb, SSQ(nssq + 1), 1.0f};
                      RUN_GEMM(pg8::EpiResidB<1>, e, ws + WS_MIX0, DM, ws + WS_WOUT0, DM, MTOK, DM, DM); }
                    PHASE_END
                    ++nssq;
                } else {
                    PHASE_BEGIN
                    { pg8::EpiOut e{(bf16_t*)(ws + WS_T1), 1024, SSQ(nssq), 1.0f / DM, 0, 0, {SSQ(SSQ_MQ), SSQ(SSQ_MQ), SSQ(SSQ_MKV), nullptr}};
                      RUN_GEMM(pg8::EpiOut, e, xb, DM, ws + WS_WD1, DM, MTOK, 1024, DM); }
                    PHASE_END
                    PHASE_BEGIN
                    { const bf16_t* T1 = (const bf16_t*)(ws + WS_T1);
                      pg8::EpiOut eq{(bf16_t*)(ws + WS_Q1), 1536, SSQ(SSQ_MQ), 1.0f / 512.0f, 0, 0, {nullptr, nullptr, nullptr, nullptr}};
                      RUN_GEMM(pg8::EpiOut, eq, T1, 1024, ws + WS_WUQ, 512, MTOK, 1536, 512);
                      pg8::EpiK1 ek{(bf16_t*)(ws + WS_K1), T1, SSQ(SSQ_MKV), IN(23)};
                      RUN_GEMM(pg8::EpiK1, ek, T1 + 512, 1024, ws + WS_WUKVK, 256, MTOK, 1024, 256);
                      pg8::EpiOutT ev{(bf16_t*)(ws + WS_VT1), MTOK, SSQ(SSQ_MKV), 1.0f / 256.0f};
                      RUN_GEMM(pg8::EpiOutT, ev, ws + WS_WUKVV, 256, T1 + 512, 1024, 1024, MTOK, 256); }
                    PHASE_END
                    PHASE_BEGIN
                    { const bf16_t* Q1 = (const bf16_t*)(ws + WS_Q1); const bf16_t* K1 = (const bf16_t*)(ws + WS_K1); const bf16_t* VT = (const bf16_t*)(ws + WS_VT1);
                      for (int rep = 0; rep < REP_ATT; ++rep) for (int r = 0;; ++r) { const int u = SNAKE(r); if (u >= 2048) break;
                          const int qb = 15 - (u >> 7), bh = u & 127, b = bh >> 4, h = bh & 15;
                          attn_unit<96, 64, 0, 3, false>(lds, Q1 + (size_t)b * SEQ * 1536 + h * 96, 1536, K1 + (size_t)b * SEQ * 1536 + h * 96, 1536,
                                               VT + (size_t)(h * 64) * MTOK + (size_t)b * SEQ, MTOK, (bf16_t*)(ws + WS_O1) + (size_t)b * SEQ * 1024 + h * 64, 1024,
                                               qb * 256, qb * 4 + 4, 0.10206207261596575f * LOG2E, IN(22), nullptr, 0.f, 0.f, wave_s); } }
                    PHASE_END
                    PHASE_BEGIN
                    { pg8::EpiResidB<1> e{nullptr, nullptr, xb, SSQ(nssq + 1), 1.0f};
                      RUN_GEMM(pg8::EpiResidB<1>, e, ws + WS_O1, DM, ws + WS_WO1, DM, MTOK, DM, DM); }
                    PHASE_END
                    ++nssq;
                }
                {
#define xmw ((const bf16_t*)(ws + WS_XM + layer * 4 * MiB))
                    PHASE_BEGIN
                    { pg8::EpiOut e{(bf16_t*)(ws + WS_XQ), 512, SSQ(nssq), 1.0f / DM, 0, 0, {nullptr, nullptr, nullptr, nullptr}};
                      RUN_GEMM(pg8::EpiOut, e, xb, DM, xmw, DM, MTOK, 512, DM); }
                    PHASE_END
                    PHASE_BEGIN
                    { const bf16_t* XQ = (const bf16_t*)(ws + WS_XQ); const bf16_t* KM = (const bf16_t*)(ws + WS_KMEM) + (size_t)layer * MMEM * 512;
                      const bf16_t* VM = (const bf16_t*)(ws + WS_VTMEM) + (size_t)layer * 512 * MMEM;
                      for (int rep = 0; rep < REP_ATT; ++rep) for (int r = 0;; ++r) { const int u = r * G + bid; if (u >= 512) break;
                          const int qb = u >> 5, bh = u & 31, b = bh >> 2, h = bh & 3;
                          attn_unit<128, 128, 2, 1, false>(lds, XQ + (size_t)b * SEQ * 512 + h * 128, 512, KM + (size_t)b * MEMLEN * 512 + h * 128, 512,
                                                 VM + (size_t)(h * 128) * MMEM + (size_t)b * MEMLEN, MMEM, (bf16_t*)(ws + WS_XO) + (size_t)b * SEQ * 512 + h * 128, 512,
                                                 qb * 256, 4, 0.08838834764831845f * LOG2E, IN(29) + layer * 128, nullptr, 0.f, 0.f, wave_s); } }
                    PHASE_END
                    PHASE_BEGIN
                    { pg8::EpiResidB<1> e{nullptr, nullptr, xb, SSQ(nssq + 1), 1.0f};
                      RUN_GEMM(pg8::EpiResidB<1>, e, ws + WS_XO, 512, xmw + 3 * 512 * 1024, 512, MTOK, DM, 512); }
                    PHASE_END
                    ++nssq;
#undef xmw
                }
            }
            const int f = layer * 2 + half;
            PHASE_BEGIN
            { pg8::EpiSwiGLU e{(bf16_t*)(ws + WS_H), SSQ(nssq)};
              for (int rep = 0; rep < REP_G1; ++rep) RUN_GEMM(pg8::EpiSwiGLU, e, xb, DM, ws + WS_FFN + f * SZ_FFN, DM, MTOK, 2 * DFF, DM);
              if constexpr (layer == 0 && half == 0) {
                  for (int l = 0; l < 2; ++l) {
                      const bf16_t* xmw = (const bf16_t*)(ws + WS_XM + l * 4 * MiB);
                      pg8::EpiOut ek{(bf16_t*)(ws + WS_KMEM) + (size_t)l * MMEM * 512, 512, SSQ(SSQ_MEM), 1.0f / DM, 0, 0, {nullptr, nullptr, nullptr, nullptr}};
                      RUN_GEMM(pg8::EpiOut, ek, memb, DM, xmw + 512 * 1024, DM, MMEM, 512, DM);
                      pg8::EpiOutT ev{(bf16_t*)(ws + WS_VTMEM) + (size_t)l * 512 * MMEM, MMEM, SSQ(SSQ_MEM), 1.0f / DM};
                      RUN_GEMM(pg8::EpiOutT, ev, xmw + 2 * 512 * 1024, DM, memb, DM, 512, MMEM, DM);
                  }
              } }
            PHASE_END
            PHASE_BEGIN
            { constexpr int RMV = (layer == 0 && half == 0) ? 0 : ((layer == 1 && half == 1) ? 2 : 1);
              pg8::EpiResidB<RMV> e{IN(0), xout, xb, SSQ(nssq + 1), 0.5f};
              RUN_GEMM(pg8::EpiResidB<RMV>, e, ws + WS_H, DFF, ws + WS_FFN + f * SZ_FFN + SZ_WGU, DFF, MTOK, DM, DFF);
              if constexpr (layer == 0 && half == 0) {
                  for (int l = 0; l < 2; ++l) pp_norm128((bf16_t*)(ws + WS_KMEM) + (size_t)l * MMEM * 512, MMEM * 4, IN(30) + l * 128, gw, NGW, lane);
              } }
            PHASE_END
            ++nssq; xcur = xout;
    }
    { constexpr int layer = 0, half = 1;
            if constexpr (half == 1) {
                if constexpr (layer == 0) {
                    PHASE_BEGIN
                    { pg8::EpiQK0 e{(bf16_t*)(ws + WS_QK0), SSQ(nssq), IN(9), IN(10), 0.125f * LOG2E};
                      RUN_GEMM(pg8::EpiQK0, e, xb, DM, ws + WS_WQK0, DM, MTOK, 2048, DM);
                      pg8::EpiOutT et{(bf16_t*)(ws + WS_VT0), MTOK, SSQ(nssq), 1.0f / DM};
                      RUN_GEMM(pg8::EpiOutT, et, ws + WS_WV0, DM, xb, DM, 1024, MTOK, DM); }
                    PHASE_END
                    PHASE_BEGIN
                    { const bf16_t* QK = (const bf16_t*)(ws + WS_QK0); const bf16_t* VT = (const bf16_t*)(ws + WS_VT0);
                      float la = IN(11)[lane] * IN(12)[lane], lb2 = IN(13)[lane] * IN(14)[lane];
                      la = wave_sum(la); lb2 = wave_sum(lb2);
                      const float lam = expf(la) - expf(lb2) + 0.2f;
                      for (int rep = 0; rep < REP_ATT; ++rep) for (int r = 0;; ++r) { const int u = SNAKE(r); if (u >= 512) break;
                          const int qb = 15 - (u >> 5), bh = u & 31, b = bh >> 2, h = bh & 3;
                          attn_unit<64, 128, 0, 0, true>(lds, QK + (size_t)b * SEQ * 2048 + h * 64, 2048, QK + (size_t)b * SEQ * 2048 + 512 + h * 64, 2048,
                                                VT + (size_t)(h * 128) * MTOK + (size_t)b * SEQ, MTOK, (bf16_t*)(ws + WS_MIX0) + (size_t)b * SEQ * 1024 + h * 128, 1024,
                                                qb * 256, qb * 4 + 4, 0.125f * LOG2E, nullptr, IN(15), lam, 0.8f, wave_s); }
                      for (int rep = 0; rep < REP_ATT; ++rep) for (int r = 0;; ++r) { const int u = SNAKE(r); if (u >= 1024) break;
                          const int qb = 15 - (u >> 6), bh = u & 63, b = bh >> 3, h = bh & 7;
                          attn_unit<64, 64, 1, 0, false>(lds, QK + (size_t)b * SEQ * 2048 + 1024 + h * 64, 2048, QK + (size_t)b * SEQ * 2048 + 1536 + h * 64, 2048,
                                               VT + (size_t)(512 + h * 64) * MTOK + (size_t)b * SEQ, MTOK, (bf16_t*)(ws + WS_MIX0) + (size_t)b * SEQ * 1024 + 512 + h * 64, 1024,
                                               qb * 256, qb * 4 + 4, 0.125f * LOG2E, nullptr, nullptr, 0.f, 0.f, wave_s); } }
                    PHASE_END
                    PHASE_BEGIN
                    { pg8::EpiResidB<1> e{nullptr, nullptr, xb, SSQ(nssq + 1), 1.0f};
                      RUN_GEMM(pg8::EpiResidB<1>, e, ws + WS_MIX0, DM, ws + WS_WOUT0, DM, MTOK, DM, DM); }
                    PHASE_END
                    ++nssq;
                } else {
                    PHASE_BEGIN
                    { pg8::EpiOut e{(bf16_t*)(ws + WS_T1), 1024, SSQ(nssq), 1.0f / DM, 0, 0, {SSQ(SSQ_MQ), SSQ(SSQ_MQ), SSQ(SSQ_MKV), nullptr}};
                      RUN_GEMM(pg8::EpiOut, e, xb, DM, ws + WS_WD1, DM, MTOK, 1024, DM); }
                    PHASE_END
                    PHASE_BEGIN
                    { const bf16_t* T1 = (const bf16_t*)(ws + WS_T1);
                      pg8::EpiOut eq{(bf16_t*)(ws + WS_Q1), 1536, SSQ(SSQ_MQ), 1.0f / 512.0f, 0, 0, {nullptr, nullptr, nullptr, nullptr}};
                      RUN_GEMM(pg8::EpiOut, eq, T1, 1024, ws + WS_WUQ, 512, MTOK, 1536, 512);
                      pg8::EpiK1 ek{(bf16_t*)(ws + WS_K1), T1, SSQ(SSQ_MKV), IN(23)};
                      RUN_GEMM(pg8::EpiK1, ek, T1 + 512, 1024, ws + WS_WUKVK, 256, MTOK, 1024, 256);
                      pg8::EpiOutT ev{(bf16_t*)(ws + WS_VT1), MTOK, SSQ(SSQ_MKV), 1.0f / 256.0f};
                      RUN_GEMM(pg8::EpiOutT, ev, ws + WS_WUKVV, 256, T1 + 512, 1024, 1024, MTOK, 256); }
                    PHASE_END
                    PHASE_BEGIN
                    { const bf16_t* Q1 = (const bf16_t*)(ws + WS_Q1); const bf16_t* K1 = (const bf16_t*)(ws + WS_K1); const bf16_t* VT = (const bf16_t*)(ws + WS_VT1);
                      for (int rep = 0; rep < REP_ATT; ++rep) for (int r = 0;; ++r) { const int u = SNAKE(r); if (u >= 2048) break;
                          const int qb = 15 - (u >> 7), bh = u & 127, b = bh >> 4, h = bh & 15;
                          attn_unit<96, 64, 0, 3, false>(lds, Q1 + (size_t)b * SEQ * 1536 + h * 96, 1536, K1 + (size_t)b * SEQ * 1536 + h * 96, 1536,
                                               VT + (size_t)(h * 64) * MTOK + (size_t)b * SEQ, MTOK, (bf16_t*)(ws + WS_O1) + (size_t)b * SEQ * 1024 + h * 64, 1024,
                                               qb * 256, qb * 4 + 4, 0.10206207261596575f * LOG2E, IN(22), nullptr, 0.f, 0.f, wave_s); } }
                    PHASE_END
                    PHASE_BEGIN
                    { pg8::EpiResidB<1> e{nullptr, nullptr, xb, SSQ(nssq + 1), 1.0f};
                      RUN_GEMM(pg8::EpiResidB<1>, e, ws + WS_O1, DM, ws + WS_WO1, DM, MTOK, DM, DM); }
                    PHASE_END
                    ++nssq;
                }
                {
#define xmw ((const bf16_t*)(ws + WS_XM + layer * 4 * MiB))
                    PHASE_BEGIN
                    { pg8::EpiOut e{(bf16_t*)(ws + WS_XQ), 512, SSQ(nssq), 1.0f / DM, 0, 0, {nullptr, nullptr, nullptr, nullptr}};
                      RUN_GEMM(pg8::EpiOut, e, xb, DM, xmw, DM, MTOK, 512, DM); }
                    PHASE_END
                    PHASE_BEGIN
                    { const bf16_t* XQ = (const bf16_t*)(ws + WS_XQ); const bf16_t* KM = (const bf16_t*)(ws + WS_KMEM) + (size_t)layer * MMEM * 512;
                      const bf16_t* VM = (const bf16_t*)(ws + WS_VTMEM) + (size_t)layer * 512 * MMEM;
                      for (int rep = 0; rep < REP_ATT; ++rep) for (int r = 0;; ++r) { const int u = r * G + bid; if (u >= 512) break;
                          const int qb = u >> 5, bh = u & 31, b = bh >> 2, h = bh & 3;
                          attn_unit<128, 128, 2, 1, false>(lds, XQ + (size_t)b * SEQ * 512 + h * 128, 512, KM + (size_t)b * MEMLEN * 512 + h * 128, 512,
                                                 VM + (size_t)(h * 128) * MMEM + (size_t)b * MEMLEN, MMEM, (bf16_t*)(ws + WS_XO) + (size_t)b * SEQ * 512 + h * 128, 512,
                                                 qb * 256, 4, 0.08838834764831845f * LOG2E, IN(29) + layer * 128, nullptr, 0.f, 0.f, wave_s); } }
                    PHASE_END
                    PHASE_BEGIN
                    { pg8::EpiResidB<1> e{nullptr, nullptr, xb, SSQ(nssq + 1), 1.0f};
                      RUN_GEMM(pg8::EpiResidB<1>, e, ws + WS_XO, 512, xmw + 3 * 512 * 1024, 512, MTOK, DM, 512); }
                    PHASE_END
                    ++nssq;
#undef xmw
                }
            }
            const int f = layer * 2 + half;
            PHASE_BEGIN
            { pg8::EpiSwiGLU e{(bf16_t*)(ws + WS_H), SSQ(nssq)};
              for (int rep = 0; rep < REP_G1; ++rep) RUN_GEMM(pg8::EpiSwiGLU, e, xb, DM, ws + WS_FFN + f * SZ_FFN, DM, MTOK, 2 * DFF, DM);
              if constexpr (layer == 0 && half == 0) {
                  for (int l = 0; l < 2; ++l) {
                      const bf16_t* xmw = (const bf16_t*)(ws + WS_XM + l * 4 * MiB);
                      pg8::EpiOut ek{(bf16_t*)(ws + WS_KMEM) + (size_t)l * MMEM * 512, 512, SSQ(SSQ_MEM), 1.0f / DM, 0, 0, {nullptr, nullptr, nullptr, nullptr}};
                      RUN_GEMM(pg8::EpiOut, ek, memb, DM, xmw + 512 * 1024, DM, MMEM, 512, DM);
                      pg8::EpiOutT ev{(bf16_t*)(ws + WS_VTMEM) + (size_t)l * 512 * MMEM, MMEM, SSQ(SSQ_MEM), 1.0f / DM};
                      RUN_GEMM(pg8::EpiOutT, ev, xmw + 2 * 512 * 1024, DM, memb, DM, 512, MMEM, DM);
                  }
              } }
            PHASE_END
            PHASE_BEGIN
            { constexpr int RMV = (layer == 0 && half == 0) ? 0 : ((layer == 1 && half == 1) ? 2 : 1);
              pg8::EpiResidB<RMV> e{IN(0), xout, xb, SSQ(nssq + 1), 0.5f};
              RUN_GEMM(pg8::EpiResidB<RMV>, e, ws + WS_H, DFF, ws + WS_FFN + f * SZ_FFN + SZ_WGU, DFF, MTOK, DM, DFF);
              if constexpr (layer == 0 && half == 0) {
                  for (int l = 0; l < 2; ++l) pp_norm128((bf16_t*)(ws + WS_KMEM) + (size_t)l * MMEM * 512, MMEM * 4, IN(30) + l * 128, gw, NGW, lane);
              } }
            PHASE_END
            ++nssq; xcur = xout;
    }
    { constexpr int layer = 1, half = 0;
            if constexpr (half == 1) {
                if constexpr (layer == 0) {
                    PHASE_BEGIN
                    { pg8::EpiQK0 e{(bf16_t*)(ws + WS_QK0), SSQ(nssq), IN(9), IN(10), 0.125f * LOG2E};
                      RUN_GEMM(pg8::EpiQK0, e, xb, DM, ws + WS_WQK0, DM, MTOK, 2048, DM);
                      pg8::EpiOutT et{(bf16_t*)(ws + WS_VT0), MTOK, SSQ(nssq), 1.0f / DM};
                      RUN_GEMM(pg8::EpiOutT, et, ws + WS_WV0, DM, xb, DM, 1024, MTOK, DM); }
                    PHASE_END
                    PHASE_BEGIN
                    { const bf16_t* QK = (const bf16_t*)(ws + WS_QK0); const bf16_t* VT = (const bf16_t*)(ws + WS_VT0);
                      float la = IN(11)[lane] * IN(12)[lane], lb2 = IN(13)[lane] * IN(14)[lane];
                      la = wave_sum(la); lb2 = wave_sum(lb2);
                      const float lam = expf(la) - expf(lb2) + 0.2f;
                      for (int rep = 0; rep < REP_ATT; ++rep) for (int r = 0;; ++r) { const int u = SNAKE(r); if (u >= 512) break;
                          const int qb = 15 - (u >> 5), bh = u & 31, b = bh >> 2, h = bh & 3;
                          attn_unit<64, 128, 0, 0, true>(lds, QK + (size_t)b * SEQ * 2048 + h * 64, 2048, QK + (size_t)b * SEQ * 2048 + 512 + h * 64, 2048,
                                                VT + (size_t)(h * 128) * MTOK + (size_t)b * SEQ, MTOK, (bf16_t*)(ws + WS_MIX0) + (size_t)b * SEQ * 1024 + h * 128, 1024,
                                                qb * 256, qb * 4 + 4, 0.125f * LOG2E, nullptr, IN(15), lam, 0.8f, wave_s); }
                      for (int rep = 0; rep < REP_ATT; ++rep) for (int r = 0;; ++r) { const int u = SNAKE(r); if (u >= 1024) break;
                          const int qb = 15 - (u >> 6), bh = u & 63, b = bh >> 3, h = bh & 7;
                          attn_unit<64, 64, 1, 0, false>(lds, QK + (size_t)b * SEQ * 2048 + 1024 + h * 64, 2048, QK + (size_t)b * SEQ * 2048 + 1536 + h * 64, 2048,
                                               VT + (size_t)(512 + h * 64) * MTOK + (size_t)b * SEQ, MTOK, (bf16_t*)(ws + WS_MIX0) + (size_t)b * SEQ * 1024 + 512 + h * 64, 1024,
                                               qb * 256, qb * 4 + 4, 0.125f * LOG2E, nullptr, nullptr, 0.f, 0.f, wave_s); } }
                    PHASE_END
                    PHASE_BEGIN
                    { pg8::EpiResidB<1> e{nullptr, nullptr, xb, SSQ(nssq + 1), 1.0f};
                      RUN_GEMM(pg8::EpiResidB<1>, e, ws + WS_MIX0, DM, ws + WS_WOUT0, DM, MTOK, DM, DM); }
                    PHASE_END
                    ++nssq;
                } else {
                    PHASE_BEGIN
                    { pg8::EpiOut e{(bf16_t*)(ws + WS_T1), 1024, SSQ(nssq), 1.0f / DM, 0, 0, {SSQ(SSQ_MQ), SSQ(SSQ_MQ), SSQ(SSQ_MKV), nullptr}};
                      RUN_GEMM(pg8::EpiOut, e, xb, DM, ws + WS_WD1, DM, MTOK, 1024, DM); }
                    PHASE_END
                    PHASE_BEGIN
                    { const bf16_t* T1 = (const bf16_t*)(ws + WS_T1);
                      pg8::EpiOut eq{(bf16_t*)(ws + WS_Q1), 1536, SSQ(SSQ_MQ), 1.0f / 512.0f, 0, 0, {nullptr, nullptr, nullptr, nullptr}};
                      RUN_GEMM(pg8::EpiOut, eq, T1, 1024, ws + WS_WUQ, 512, MTOK, 1536, 512);
                      pg8::EpiK1 ek{(bf16_t*)(ws + WS_K1), T1, SSQ(SSQ_MKV), IN(23)};
                      RUN_GEMM(pg8::EpiK1, ek, T1 + 512, 1024, ws + WS_WUKVK, 256, MTOK, 1024, 256);
                      pg8::EpiOutT ev{(bf16_t*)(ws + WS_VT1), MTOK, SSQ(SSQ_MKV), 1.0f / 256.0f};
                      RUN_GEMM(pg8::EpiOutT, ev, ws + WS_WUKVV, 256, T1 + 512, 1024, 1024, MTOK, 256); }
                    PHASE_END
                    PHASE_BEGIN
                    { const bf16_t* Q1 = (const bf16_t*)(ws + WS_Q1); const bf16_t* K1 = (const bf16_t*)(ws + WS_K1); const bf16_t* VT = (const bf16_t*)(ws + WS_VT1);
                      for (int rep = 0; rep < REP_ATT; ++rep) for (int r = 0;; ++r) { const int u = SNAKE(r); if (u >= 2048) break;
                          const int qb = 15 - (u >> 7), bh = u & 127, b = bh >> 4, h = bh & 15;
                          attn_unit<96, 64, 0, 3, false>(lds, Q1 + (size_t)b * SEQ * 1536 + h * 96, 1536, K1 + (size_t)b * SEQ * 1536 + h * 96, 1536,
                                               VT + (size_t)(h * 64) * MTOK + (size_t)b * SEQ, MTOK, (bf16_t*)(ws + WS_O1) + (size_t)b * SEQ * 1024 + h * 64, 1024,
                                               qb * 256, qb * 4 + 4, 0.10206207261596575f * LOG2E, IN(22), nullptr, 0.f, 0.f, wave_s); } }
                    PHASE_END
                    PHASE_BEGIN
                    { pg8::EpiResidB<1> e{nullptr, nullptr, xb, SSQ(nssq + 1), 1.0f};
                      RUN_GEMM(pg8::EpiResidB<1>, e, ws + WS_O1, DM, ws + WS_WO1, DM, MTOK, DM, DM); }
                    PHASE_END
                    ++nssq;
                }
                {
#define xmw ((const bf16_t*)(ws + WS_XM + layer * 4 * MiB))
                    PHASE_BEGIN
                    { pg8::EpiOut e{(bf16_t*)(ws + WS_XQ), 512, SSQ(nssq), 1.0f / DM, 0, 0, {nullptr, nullptr, nullptr, nullptr}};
                      RUN_GEMM(pg8::EpiOut, e, xb, DM, xmw, DM, MTOK, 512, DM); }
                    PHASE_END
                    PHASE_BEGIN
                    { const bf16_t* XQ = (const bf16_t*)(ws + WS_XQ); const bf16_t* KM = (const bf16_t*)(ws + WS_KMEM) + (size_t)layer * MMEM * 512;
                      const bf16_t* VM = (const bf16_t*)(ws + WS_VTMEM) + (size_t)layer * 512 * MMEM;
                      for (int rep = 0; rep < REP_ATT; ++rep) for (int r = 0;; ++r) { const int u = r * G + bid; if (u >= 512) break;
                          const int qb = u >> 5, bh = u & 31, b = bh >> 2, h = bh & 3;
                          attn_unit<128, 128, 2, 1, false>(lds, XQ + (size_t)b * SEQ * 512 + h * 128, 512, KM + (size_t)b * MEMLEN * 512 + h * 128, 512,
                                                 VM + (size_t)(h * 128) * MMEM + (size_t)b * MEMLEN, MMEM, (bf16_t*)(ws + WS_XO) + (size_t)b * SEQ * 512 + h * 128, 512,
                                                 qb * 256, 4, 0.08838834764831845f * LOG2E, IN(29) + layer * 128, nullptr, 0.f, 0.f, wave_s); } }
                    PHASE_END
                    PHASE_BEGIN
                    { pg8::EpiResidB<1> e{nullptr, nullptr, xb, SSQ(nssq + 1), 1.0f};
                      RUN_GEMM(pg8::EpiResidB<1>, e, ws + WS_XO, 512, xmw + 3 * 512 * 1024, 512, MTOK, DM, 512); }
                    PHASE_END
                    ++nssq;
#undef xmw
                }
            }
            const int f = layer * 2 + half;
            PHASE_BEGIN
            { pg8::EpiSwiGLU e{(bf16_t*)(ws + WS_H), SSQ(nssq)};
              for (int rep = 0; rep < REP_G1; ++rep) RUN_GEMM(pg8::EpiSwiGLU, e, xb, DM, ws + WS_FFN + f * SZ_FFN, DM, MTOK, 2 * DFF, DM);
              if constexpr (layer == 0 && half == 0) {
                  for (int l = 0; l < 2; ++l) {
                      const bf16_t* xmw = (const bf16_t*)(ws + WS_XM + l * 4 * MiB);
                      pg8::EpiOut ek{(bf16_t*)(ws + WS_KMEM) + (size_t)l * MMEM * 512, 512, SSQ(SSQ_MEM), 1.0f / DM, 0, 0, {nullptr, nullptr, nullptr, nullptr}};
                      RUN_GEMM(pg8::EpiOut, ek, memb, DM, xmw + 512 * 1024, DM, MMEM, 512, DM);
                      pg8::EpiOutT ev{(bf16_t*)(ws + WS_VTMEM) + (size_t)l * 512 * MMEM, MMEM, SSQ(SSQ_MEM), 1.0f / DM};
                      RUN_GEMM(pg8::EpiOutT, ev, xmw + 2 * 512 * 1024, DM, memb, DM, 512, MMEM, DM);
                  }
              } }
            PHASE_END
            PHASE_BEGIN
            { constexpr int RMV = (layer == 0 && half == 0) ? 0 : ((layer == 1 && half == 1) ? 2 : 1);
              pg8::EpiResidB<RMV> e{IN(0), xout, xb, SSQ(nssq + 1), 0.5f};
              RUN_GEMM(pg8::EpiResidB<RMV>, e, ws + WS_H, DFF, ws + WS_FFN + f * SZ_FFN + SZ_WGU, DFF, MTOK, DM, DFF);
              if constexpr (layer == 0 && half == 0) {
                  for (int l = 0; l < 2; ++l) pp_norm128((bf16_t*)(ws + WS_KMEM) + (size_t)l * MMEM * 512, MMEM * 4, IN(30) + l * 128, gw, NGW, lane);
              } }
            PHASE_END
            ++nssq; xcur = xout;
    }
    { constexpr int layer = 1, half = 1;
            if constexpr (half == 1) {
                if constexpr (layer == 0) {
                    PHASE_BEGIN
                    { pg8::EpiQK0 e{(bf16_t*)(ws + WS_QK0), SSQ(nssq), IN(9), IN(10), 0.125f * LOG2E};
                      RUN_GEMM(pg8::EpiQK0, e, xb, DM, ws + WS_WQK0, DM, MTOK, 2048, DM);
                      pg8::EpiOutT et{(bf16_t*)(ws + WS_VT0), MTOK, SSQ(nssq), 1.0f / DM};
                      RUN_GEMM(pg8::EpiOutT, et, ws + WS_WV0, DM, xb, DM, 1024, MTOK, DM); }
                    PHASE_END
                    PHASE_BEGIN
                    { const bf16_t* QK = (const bf16_t*)(ws + WS_QK0); const bf16_t* VT = (const bf16_t*)(ws + WS_VT0);
                      float la = IN(11)[lane] * IN(12)[lane], lb2 = IN(13)[lane] * IN(14)[lane];
                      la = wave_sum(la); lb2 = wave_sum(lb2);
                      const float lam = expf(la) - expf(lb2) + 0.2f;
                      for (int rep = 0; rep < REP_ATT; ++rep) for (int r = 0;; ++r) { const int u = SNAKE(r); if (u >= 512) break;
                          const int qb = 15 - (u >> 5), bh = u & 31, b = bh >> 2, h = bh & 3;
                          attn_unit<64, 128, 0, 0, true>(lds, QK + (size_t)b * SEQ * 2048 + h * 64, 2048, QK + (size_t)b * SEQ * 2048 + 512 + h * 64, 2048,
                                                VT + (size_t)(h * 128) * MTOK + (size_t)b * SEQ, MTOK, (bf16_t*)(ws + WS_MIX0) + (size_t)b * SEQ * 1024 + h * 128, 1024,
                                                qb * 256, qb * 4 + 4, 0.125f * LOG2E, nullptr, IN(15), lam, 0.8f, wave_s); }
                      for (int rep = 0; rep < REP_ATT; ++rep) for (int r = 0;; ++r) { const int u = SNAKE(r); if (u >= 1024) break;
                          const int qb = 15 - (u >> 6), bh = u & 63, b = bh >> 3, h = bh & 7;
                          attn_unit<64, 64, 1, 0, false>(lds, QK + (size_t)b * SEQ * 2048 + 1024 + h * 64, 2048, QK + (size_t)b * SEQ * 2048 + 1536 + h * 64, 2048,
                                               VT + (size_t)(512 + h * 64) * MTOK + (size_t)b * SEQ, MTOK, (bf16_t*)(ws + WS_MIX0) + (size_t)b * SEQ * 1024 + 512 + h * 64, 1024,
                                               qb * 256, qb * 4 + 4, 0.125f * LOG2E, nullptr, nullptr, 0.f, 0.f, wave_s); } }
                    PHASE_END
                    PHASE_BEGIN
                    { pg8::EpiResidB<1> e{nullptr, nullptr, xb, SSQ(nssq + 1), 1.0f};
                      RUN_GEMM(pg8::EpiResidB<1>, e, ws + WS_MIX0, DM, ws + WS_WOUT0, DM, MTOK, DM, DM); }
                    PHASE_END
                    ++nssq;
                } else {
                    PHASE_BEGIN
                    { pg8::EpiOut e{(bf16_t*)(ws + WS_T1), 1024, SSQ(nssq), 1.0f / DM, 0, 0, {SSQ(SSQ_MQ), SSQ(SSQ_MQ), SSQ(SSQ_MKV), nullptr}};
                      RUN_GEMM(pg8::EpiOut, e, xb, DM, ws + WS_WD1, DM, MTOK, 1024, DM); }
                    PHASE_END
                    PHASE_BEGIN
                    { const bf16_t* T1 = (const bf16_t*)(ws + WS_T1);
                      pg8::EpiOut eq{(bf16_t*)(ws + WS_Q1), 1536, SSQ(SSQ_MQ), 1.0f / 512.0f, 0, 0, {nullptr, nullptr, nullptr, nullptr}};
                      RUN_GEMM(pg8::EpiOut, eq, T1, 1024, ws + WS_WUQ, 512, MTOK, 1536, 512);
                      pg8::EpiK1 ek{(bf16_t*)(ws + WS_K1), T1, SSQ(SSQ_MKV), IN(23)};
                      RUN_GEMM(pg8::EpiK1, ek, T1 + 512, 1024, ws + WS_WUKVK, 256, MTOK, 1024, 256);
                      pg8::EpiOutT ev{(bf16_t*)(ws + WS_VT1), MTOK, SSQ(SSQ_MKV), 1.0f / 256.0f};
                      RUN_GEMM(pg8::EpiOutT, ev, ws + WS_WUKVV, 256, T1 + 512, 1024, 1024, MTOK, 256); }
                    PHASE_END
                    PHASE_BEGIN
                    { const bf16_t* Q1 = (const bf16_t*)(ws + WS_Q1); const bf16_t* K1 = (const bf16_t*)(ws + WS_K1); const bf16_t* VT = (const bf16_t*)(ws + WS_VT1);
                      for (int rep = 0; rep < REP_ATT; ++rep) for (int r = 0;; ++r) { const int u = SNAKE(r); if (u >= 2048) break;
                          const int qb = 15 - (u >> 7), bh = u & 127, b = bh >> 4, h = bh & 15;
                          attn_unit<96, 64, 0, 3, false>(lds, Q1 + (size_t)b * SEQ * 1536 + h * 96, 1536, K1 + (size_t)b * SEQ * 1536 + h * 96, 1536,
                                               VT + (size_t)(h * 64) * MTOK + (size_t)b * SEQ, MTOK, (bf16_t*)(ws + WS_O1) + (size_t)b * SEQ * 1024 + h * 64, 1024,
                                               qb * 256, qb * 4 + 4, 0.10206207261596575f * LOG2E, IN(22), nullptr, 0.f, 0.f, wave_s); } }
                    PHASE_END
                    PHASE_BEGIN
                    { pg8::EpiResidB<1> e{nullptr, nullptr, xb, SSQ(nssq + 1), 1.0f};
                      RUN_GEMM(pg8::EpiResidB<1>, e, ws + WS_O1, DM, ws + WS_WO1, DM, MTOK, DM, DM); }
                    PHASE_END
                    ++nssq;
                }
                {
#define xmw ((const bf16_t*)(ws + WS_XM + layer * 4 * MiB))
                    PHASE_BEGIN
                    { pg8::EpiOut e{(bf16_t*)(ws + WS_XQ), 512, SSQ(nssq), 1.0f / DM, 0, 0, {nullptr, nullptr, nullptr, nullptr}};
                      RUN_GEMM(pg8::EpiOut, e, xb, DM, xmw, DM, MTOK, 512, DM); }
                    PHASE_END
                    PHASE_BEGIN
                    { const bf16_t* XQ = (const bf16_t*)(ws + WS_XQ); const bf16_t* KM = (const bf16_t*)(ws + WS_KMEM) + (size_t)layer * MMEM * 512;
                      const bf16_t* VM = (const bf16_t*)(ws + WS_VTMEM) + (size_t)layer * 512 * MMEM;
                      for (int rep = 0; rep < REP_ATT; ++rep) for (int r = 0;; ++r) { const int u = r * G + bid; if (u >= 512) break;
                          const int qb = u >> 5, bh = u & 31, b = bh >> 2, h = bh & 3;
                          attn_unit<128, 128, 2, 1, false>(lds, XQ + (size_t)b * SEQ * 512 + h * 128, 512, KM + (size_t)b * MEMLEN * 512 + h * 128, 512,
                                                 VM + (size_t)(h * 128) * MMEM + (size_t)b * MEMLEN, MMEM, (bf16_t*)(ws + WS_XO) + (size_t)b * SEQ * 512 + h * 128, 512,
                                                 qb * 256, 4, 0.08838834764831845f * LOG2E, IN(29) + layer * 128, nullptr, 0.f, 0.f, wave_s); } }
                    PHASE_END
                    PHASE_BEGIN
                    { pg8::EpiResidB<1> e{nullptr, nullptr, xb, SSQ(nssq + 1), 1.0f};
                      RUN_GEMM(pg8::EpiResidB<1>, e, ws + WS_XO, 512, xmw + 3 * 512 * 1024, 512, MTOK, DM, 512); }
                    PHASE_END
                    ++nssq;
#undef xmw
                }
            }
            const int f = layer * 2 + half;
            PHASE_BEGIN
            { pg8::EpiSwiGLU e{(bf16_t*)(ws + WS_H), SSQ(nssq)};
              for (int rep = 0; rep < REP_G1; ++rep) RUN_GEMM(pg8::EpiSwiGLU, e, xb, DM, ws + WS_FFN + f * SZ_FFN, DM, MTOK, 2 * DFF, DM);
              if constexpr (layer == 0 && half == 0) {
                  for (int l = 0; l < 2; ++l) {
                      const bf16_t* xmw = (const bf16_t*)(ws + WS_XM + l * 4 * MiB);
                      pg8::EpiOut ek{(bf16_t*)(ws + WS_KMEM) + (size_t)l * MMEM * 512, 512, SSQ(SSQ_MEM), 1.0f / DM, 0, 0, {nullptr, nullptr, nullptr, nullptr}};
                      RUN_GEMM(pg8::EpiOut, ek, memb, DM, xmw + 512 * 1024, DM, MMEM, 512, DM);
                      pg8::EpiOutT ev{(bf16_t*)(ws + WS_VTMEM) + (size_t)l * 512 * MMEM, MMEM, SSQ(SSQ_MEM), 1.0f / DM};
                      RUN_GEMM(pg8::EpiOutT, ev, xmw + 2 * 512 * 1024, DM, memb, DM, 512, MMEM, DM);
                  }
              } }
            PHASE_END
            PHASE_BEGIN
            { constexpr int RMV = (layer == 0 && half == 0) ? 0 : ((layer == 1 && half == 1) ? 2 : 1);
              pg8::EpiResidB<RMV> e{IN(0), xout, xb, SSQ(nssq + 1), 0.5f};
              RUN_GEMM(pg8::EpiResidB<RMV>, e, ws + WS_H, DFF, ws + WS_FFN + f * SZ_FFN + SZ_WGU, DFF, MTOK, DM, DFF);
              if constexpr (layer == 0 && half == 0) {
                  for (int l = 0; l < 2; ++l) pp_norm128((bf16_t*)(ws + WS_KMEM) + (size_t)l * MMEM * 512, MMEM * 4, IN(30) + l * 128, gw, NGW, lane);
              } }
            PHASE_END
            ++nssq; xcur = xout;
    }
}

constexpr int N_PHASES = 22;
extern "C" void kernel_launch(void* const* d_in, const int* in_sizes, int n_in, void* d_out, int out_size, void* d_ws, size_t ws_size, hipStream_t stream) {
    static int grid = 0;
    if (grid == 0) {
        if (n_in != 32 || ws_size < WS_END) { fprintf(stderr, "kernel_launch: unexpected n_in %d / ws %zu\n", n_in, ws_size); grid = -1; return; }
        int dev = 0, cus = 0, per_cu = 0;
        hipGetDevice(&dev);
        hipDeviceGetAttribute(&cus, hipDeviceAttributeMultiprocessorCount, dev);
        hipFuncSetAttribute((const void*)fwd_kernel, hipFuncAttributeMaxDynamicSharedMemorySize, LDS_BYTES);
        hipOccupancyMaxActiveBlocksPerMultiprocessor(&per_cu, (const void*)fwd_kernel, 512, LDS_BYTES);
        if (per_cu < 1) per_cu = 1;
        grid = cus * per_cu;
        fprintf(stderr, "kernel_launch: cus %d per_cu %d grid %d\n", cus, per_cu, grid);
    }
    if (grid < 0) return;
    Params p{};
    for (int i = 0; i < 32; ++i) p.in[i] = (const float*)d_in[i];
    p.out = (float*)d_out; p.ws = (unsigned char*)d_ws;
    (void)hipMemsetAsync((char*)d_ws + WS_BAR, 0, BAR_BYTES, stream);
#ifdef MULTI_LAUNCH
    for (int k = 0; k < N_PHASES; ++k) { p.lo = k; p.hi = k + 1; hipLaunchKernelGGL(fwd_kernel, dim3(grid), dim3(512), LDS_BYTES, stream, p); }
#else
    p.lo = 0; p.hi = N_PHASES;
    void* args[] = {&p};
    hipError_t e = hipLaunchCooperativeKernel((const void*)fwd_kernel, dim3(grid), dim3(512), args, LDS_BYTES, stream);
    if (e != hipSuccess) fprintf(stderr, "cooperative launch failed: %s (grid %d)\n", hipGetErrorString(e), grid);
#endif
}
```

```cpp
#include <hip/hip_runtime.h>
#include <hip/hip_cooperative_groups.h>
#include <cstdio>
#include <cstdint>
namespace cg = cooperative_groups;

#define LAS __attribute__((address_space(3)))
typedef unsigned short bf16_t;
typedef short bf16x8 __attribute__((ext_vector_type(8)));
typedef short s16x4 __attribute__((ext_vector_type(4)));
typedef float f32x4 __attribute__((ext_vector_type(4)));
typedef float f32x16 __attribute__((ext_vector_type(16)));
typedef unsigned u32x4 __attribute__((ext_vector_type(4)));
typedef unsigned u32x2 __attribute__((ext_vector_type(2)));
typedef float f32x2_t __attribute__((ext_vector_type(2)));
typedef __bf16 bf16x2_t __attribute__((ext_vector_type(2)));


__device__ __forceinline__ int lane_now() { int l; asm volatile("v_mbcnt_lo_u32_b32 %0, -1, 0\n\tv_mbcnt_hi_u32_b32 %0, -1, %0" : "=v"(l)); return l; }

__device__ __forceinline__ float ssq_sum(const float* p) {
    const f32x4 a = *(const f32x4*)p, b = *(const f32x4*)(p + 4), c = *(const f32x4*)(p + 8), d = *(const f32x4*)(p + 12);
    return (((a[0] + a[1]) + (a[2] + a[3])) + ((b[0] + b[1]) + (b[2] + b[3]))) + (((c[0] + c[1]) + (c[2] + c[3])) + ((d[0] + d[1]) + (d[2] + d[3])));
}

__device__ __forceinline__ float fadd_s(float a, float b) { float r = a + b; asm("" : "+v"(r)); return r; }
__device__ __forceinline__ float fmul_s(float a, float b) { float r = a * b; asm("" : "+v"(r)); return r; }
constexpr int DM = 1024, NB = 8, SEQ = 4096, MTOK = NB * SEQ, DFF = 2816, MEMLEN = 256, MMEM = NB * MEMLEN;
constexpr float EPS = 1e-6f;
constexpr float LOG2E = 1.4426950408889634f;

__device__ __forceinline__ unsigned cvtpk(float lo, float hi) { f32x2_t v = {lo, hi}; bf16x2_t b = __builtin_convertvector(v, bf16x2_t); return __builtin_bit_cast(unsigned, b); }
__device__ __forceinline__ float bf2f(unsigned short h) { return __uint_as_float(((unsigned)h) << 16); }
__device__ __forceinline__ float bflo(unsigned w) { return __uint_as_float(w << 16); }
__device__ __forceinline__ float bfhi(unsigned w) { return __uint_as_float(w & 0xffff0000u); }

__device__ const double ROPE_REV[32] = {0.15915494309189535, 0.11934937021124886, 0.08949940160889101, 0.06711508300522726, 0.050329212104487035, 0.03774158471741977, 0.0283021958306234, 0.02122365276477766, 0.015915494309189534, 0.011934937021124886, 0.008949940160889102, 0.006711508300522725, 0.005032921210448704, 0.003774158471741977, 0.00283021958306234, 0.0021223652764777662, 0.0015915494309189536, 0.0011934937021124885, 0.0008949940160889102, 0.0006711508300522726, 0.0005032921210448703, 0.00037741584717419774, 0.00028302195830623395, 0.0002122365276477766, 0.00015915494309189535, 0.00011934937021124886, 8.949940160889102e-05, 6.711508300522725e-05, 5.0329212104487035e-05, 3.774158471741978e-05, 2.8302195830623396e-05, 2.122365276477766e-05};
__device__ __forceinline__ void rope_cs(int pos, int idx64, float& cs, float& sn) {
    const double rev = (double)pos * ROPE_REV[idx64];
    const float fr = (float)(rev - __builtin_rint(rev));
    cs = __builtin_amdgcn_cosf(fr); sn = __builtin_amdgcn_sinf(fr);
    asm volatile("" : "+v"(cs), "+v"(sn));
}

namespace pg8 {
constexpr int BM = 256, BK = 64, HALF = 128, HTB = HALF * BK * 2, STAGE_BYTES = 8 * HTB, NXCD = 8, WGM = 8;
__device__ __forceinline__ int lds_byte(int r, int c) { const int st = (r >> 4) * 2 + (c >> 5), rr = r & 15, cc = c & 31, ob = rr * 64 + cc * 2; return st * 1024 + (ob ^ (((ob >> 9) & 1) << 5)); }
__device__ __forceinline__ void stage_rc(int b, int& R, int& C) { const int st = b / 1024, sb = b % 1024, swz = sb ^ (((sb >> 9) & 1) << 5); R = (st >> 1) * 16 + swz / 64; C = (st & 1) * 32 + (swz % 64) / 2; }
__device__ __forceinline__ int perm32(int rho) { const int n = rho >> 4, i = rho & 15; return 8 * (i >> 2) + 4 * n + (i & 3); }
struct Unit { int pm, pn; };
struct Gemm { const bf16_t* A; const bf16_t* Bt; int M, N, K, lda, ldb; };
struct StaticOrder {
    int nM, nN, nwg, G, c;
    __device__ void init(int M, int N, int G_, int c_) { nM = M / BM; nN = N / BM; nwg = nM * nN; G = G_; c = c_; }
    __device__ bool next(int i, Unit& u) const {
        const long L = (long)i * G + c; if (L >= nwg) return false;
        int wgid = (int)L; { const int q = nwg / NXCD, r = nwg % NXCD, xcd = wgid % NXCD, off = wgid / NXCD; wgid = (xcd < r ? xcd * (q + 1) : r * (q + 1) + (xcd - r) * q) + off; }
        const int nig = WGM * nN, gid = wgid / nig, fm = gid * WGM, gsz = (nM - fm) < WGM ? (nM - fm) : WGM;
        u.pm = fm + ((wgid % nig) % gsz); u.pn = (wgid % nig) / gsz; return true;
    }
};
template <class Epi>
__device__ __forceinline__ void gemm_phase(LAS unsigned char* lds, const Gemm g, const StaticOrder& S, const Epi& E, int wave_s) {
    const int tid = wave_s * 64 + lane_now(), wid = __builtin_amdgcn_readfirstlane(tid >> 6), lane = tid & 63, wr = wid >> 2, wc = wid & 3, fr = lane & 15, fq = lane >> 4;
    const int K = g.K, nt = K / BK;
    unsigned voffA[2], voffB[2];
#pragma unroll
    for (int i = 0; i < 2; ++i) { int R, C; stage_rc(tid * 16 + i * 8192, R, C); const int Rb = (R & ~31) + perm32(R & 31);
        voffA[i] = (unsigned)(R * g.lda + C) * 2u; voffB[i] = (unsigned)(Rb * g.ldb + C) * 2u; }
    const size_t kstep = (size_t)(BK * 2);
    const size_t hstepA = (size_t)HALF * g.lda * 2, hstepB = (size_t)HALF * g.ldb * 2;
    const size_t tstepA = 2 * hstepA, tstepB = 2 * hstepB;
    const unsigned ldsw = (unsigned)wid * 1024u;
    const int aoff = lds_byte(wr * 64 + fr, fq * 8), boff = lds_byte(wc * 32 + fr, fq * 8);
#define PG8_SA(b, h) (((b) * 2 + (h)) * HTB)
#define PG8_SB(b, h) ((4 + (b) * 2 + (h)) * HTB)
#define PG8_STAGE(bufoff, gbase, voff) do { _Pragma("unroll") for (int _i = 0; _i < 2; ++_i) \
        __builtin_amdgcn_global_load_lds((const unsigned*)((const char*)(gbase) + (voff)[_i]), (LAS unsigned*)(lds + (bufoff) + ldsw + _i * 8192), 16, 0, 0); } while (0)
#define PG8_LDA(dst, b, h) do { _Pragma("unroll") for (int m = 0; m < 4; ++m) _Pragma("unroll") for (int k = 0; k < 2; ++k) dst[m][k] = *(const LAS bf16x8*)(lds + PG8_SA(b, h) + aoff + m * 2048 + k * 1024); } while (0)
#define PG8_LDB(dst, b, h) do { _Pragma("unroll") for (int n = 0; n < 2; ++n) _Pragma("unroll") for (int k = 0; k < 2; ++k) dst[n][k] = *(const LAS bf16x8*)(lds + PG8_SB(b, h) + boff + n * 2048 + k * 1024); } while (0)
#define PG8_MMA(ai, bj, At, Bt) do { __builtin_amdgcn_s_setprio(1); _Pragma("unroll") for (int m = 0; m < 4; ++m) _Pragma("unroll") for (int n = 0; n < 2; ++n) _Pragma("unroll") for (int k = 0; k < 2; ++k) \
        acc[ai][bj][m][n] = __builtin_amdgcn_mfma_f32_16x16x32_bf16(Bt[n][k], At[m][k], acc[ai][bj][m][n], 0, 0, 0); __builtin_amdgcn_s_setprio(0); } while (0)
#define PG8_WAIT_V(n) asm volatile("s_waitcnt vmcnt(" #n ")" ::: "memory")
#define PG8_WAIT_L(n) asm volatile("s_waitcnt lgkmcnt(" #n ")" ::: "memory")
#define PG8_BAR __builtin_amdgcn_s_barrier()
#define PG8_SCHED __builtin_amdgcn_sched_barrier(0)
    Unit cur, nxt; int ui = 0;
    if (!S.next(0, cur)) return;
    f32x4 acc[2][2][4][2];
#pragma unroll
    for (int a = 0; a < 2; ++a)
#pragma unroll
        for (int b = 0; b < 2; ++b)
#pragma unroll
            for (int m = 0; m < 4; ++m)
#pragma unroll
                for (int n = 0; n < 2; ++n) acc[a][b][m][n] = (f32x4){0.f, 0.f, 0.f, 0.f};
    bf16x8 At[4][2], B0[2][2], B1[2][2];
    const char* cA = (const char*)g.A + (size_t)cur.pm * tstepA; const char* cB = (const char*)g.Bt + (size_t)cur.pn * tstepB;
    PG8_STAGE(PG8_SB(0, 0), cB, voffB); PG8_STAGE(PG8_SB(0, 1), cB + hstepB, voffB); PG8_STAGE(PG8_SA(0, 0), cA, voffA); PG8_STAGE(PG8_SA(0, 1), cA + hstepA, voffA);
    if (wr == 1) PG8_BAR;
    PG8_WAIT_V(2); PG8_BAR;
    PG8_STAGE(PG8_SB(1, 0), cB + kstep, voffB); PG8_STAGE(PG8_SA(1, 0), cA + kstep, voffA); PG8_STAGE(PG8_SB(1, 1), cB + hstepB + kstep, voffB);
    PG8_WAIT_V(6); PG8_BAR;
    for (;;) {
        const bool has_next = S.next(ui + 1, nxt);
        const char* nA = has_next ? (const char*)g.A + (size_t)nxt.pm * tstepA : cA; const char* nB = has_next ? (const char*)g.Bt + (size_t)nxt.pn * tstepB : cB;
        for (int t = 0; t < nt; t += 2) {
            const bool last = (t == nt - 2);
            const char* a1 = cA + (size_t)(t + 1) * kstep;
            const char* a2 = last ? nA : cA + (size_t)(t + 2) * kstep; const char* b2 = last ? nB : cB + (size_t)(t + 2) * kstep;
            const char* a3 = a2 + kstep; const char* b3 = b2 + kstep;
            PG8_LDB(B0, 0, 0); PG8_LDB(B1, 0, 1); PG8_SCHED; PG8_LDA(At, 0, 0); PG8_STAGE(PG8_SA(1, 1), a1 + hstepA, voffA);
            PG8_WAIT_V(8); PG8_WAIT_L(0); PG8_BAR; PG8_MMA(0, 0, At, B0); PG8_MMA(0, 1, At, B1); PG8_BAR; PG8_SCHED;
            PG8_LDA(At, 0, 1); PG8_STAGE(PG8_SB(0, 0), b2, voffB); PG8_STAGE(PG8_SB(0, 1), b2 + hstepB, voffB); PG8_STAGE(PG8_SA(0, 0), a2, voffA);
            PG8_WAIT_V(8); PG8_WAIT_L(0); PG8_BAR; PG8_MMA(1, 0, At, B0); PG8_MMA(1, 1, At, B1); PG8_BAR; PG8_SCHED;
            PG8_LDB(B0, 1, 0); PG8_LDB(B1, 1, 1); PG8_SCHED; PG8_LDA(At, 1, 0); PG8_STAGE(PG8_SA(0, 1), a2 + hstepA, voffA);
            PG8_WAIT_V(8); PG8_WAIT_L(0); PG8_BAR; PG8_MMA(0, 0, At, B0); PG8_MMA(0, 1, At, B1); PG8_BAR; PG8_SCHED;
            PG8_LDA(At, 1, 1); PG8_STAGE(PG8_SB(1, 0), b3, voffB); PG8_STAGE(PG8_SB(1, 1), b3 + hstepB, voffB); PG8_STAGE(PG8_SA(1, 0), a3, voffA);
            PG8_WAIT_V(8); PG8_WAIT_L(0); PG8_BAR; PG8_MMA(1, 0, At, B0); PG8_MMA(1, 1, At, B1); PG8_BAR; PG8_SCHED;
        }
        if (wr == 0) PG8_BAR;
        E(acc, cur, wr, wc, fr, fq);
        if (!has_next) break;
#pragma unroll
        for (int a = 0; a < 2; ++a)
#pragma unroll
            for (int b = 0; b < 2; ++b)
#pragma unroll
                for (int m = 0; m < 4; ++m)
#pragma unroll
                    for (int n = 0; n < 2; ++n) acc[a][b][m][n] = (f32x4){0.f, 0.f, 0.f, 0.f};
        cur = nxt; cA = nA; cB = nB; ++ui;
        if (wr == 1) PG8_BAR;
    }
    PG8_WAIT_V(0);
    PG8_BAR;
#undef PG8_SA
#undef PG8_SB
#undef PG8_STAGE
#undef PG8_LDA
#undef PG8_LDB
#undef PG8_MMA
#undef PG8_WAIT_V
#undef PG8_WAIT_L
#undef PG8_BAR
#undef PG8_SCHED
}

struct EpiSwiGLU {
    bf16_t* H; const float* ssq;
    __device__ __forceinline__ void operator()(const f32x4 (&acc)[2][2][4][2], const Unit& u, int wr, int wc, int fr, int fq) const {
        const int row0 = u.pm * BM + wr * 64 + fr, col0 = u.pn * 128 + wc * 32 + 8 * fq;
#pragma unroll
        for (int ai = 0; ai < 2; ++ai)
#pragma unroll
            for (int m = 0; m < 4; ++m) {
                const int row = row0 + ai * HALF + m * 16;
                const float rs = 1.0f / sqrtf(ssq_sum(ssq + (size_t)row * 16) * (1.0f / DM) + EPS);
                float hv[8];
#pragma unroll
                for (int n = 0; n < 2; ++n)
#pragma unroll
                    for (int e = 0; e < 4; ++e) {
                        const float gg = acc[ai][0][m][n][e] * rs, uu = acc[ai][1][m][n][e] * rs;
                        const float den = 1.0f + __builtin_amdgcn_exp2f(-gg * LOG2E);
                        hv[n * 4 + e] = gg * uu * __builtin_amdgcn_rcpf(den);
                    }
                u32x4 w; w.x = cvtpk(hv[0], hv[1]); w.y = cvtpk(hv[2], hv[3]); w.z = cvtpk(hv[4], hv[5]); w.w = cvtpk(hv[6], hv[7]);
                *(u32x4*)(H + (size_t)row * DFF + col0) = w;
            }
    }
};
template <int RM> struct EpiResidB {
    const float* xf; float* outf; bf16_t* xb; float* ssq_out; float alpha;
    __device__ __forceinline__ void operator()(const f32x4 (&acc)[2][2][4][2], const Unit& u, int wr, int wc, int fr, int fq) const {
        const int row0 = u.pm * BM + wr * 64 + fr, col0 = u.pn * BM + wc * 32 + 8 * fq;
        u32x4 xv[RM == 0 ? 1 : 2][RM == 0 ? 1 : 4][RM == 0 ? 1 : 2];
        if (RM != 0) {
#pragma unroll
            for (int ai = 0; ai < 2; ++ai)
#pragma unroll
                for (int m = 0; m < 4; ++m)
#pragma unroll
                    for (int bj = 0; bj < 2; ++bj) xv[RM == 0 ? 0 : ai][RM == 0 ? 0 : m][RM == 0 ? 0 : bj] = *(const u32x4*)(xb + (size_t)(row0 + ai * HALF + m * 16) * DM + col0 + bj * HALF);
        }
#pragma unroll
        for (int ai = 0; ai < 2; ++ai)
#pragma unroll
            for (int m = 0; m < 4; ++m) {
                const int row = row0 + ai * HALF + m * 16; float s = 0.f;
#pragma unroll
                for (int bj = 0; bj < 2; ++bj) {
                    const size_t off = (size_t)row * DM + col0 + bj * HALF;
                    f32x4 v0, v1;
                    if (RM == 0) { v0 = *(const f32x4*)(xf + off); v1 = *(const f32x4*)(xf + off + 4); }
                    else { const u32x4 w = xv[RM == 0 ? 0 : ai][RM == 0 ? 0 : m][RM == 0 ? 0 : bj]; v0 = (f32x4){bflo(w.x), bfhi(w.x), bflo(w.y), bfhi(w.y)}; v1 = (f32x4){bflo(w.z), bfhi(w.z), bflo(w.w), bfhi(w.w)}; }
                    v0 = v0 + acc[ai][bj][m][0] * alpha; v1 = v1 + acc[ai][bj][m][1] * alpha;
                    if (RM == 2) { *(f32x4*)(outf + off) = v0; *(f32x4*)(outf + off + 4) = v1; }
                    else {
                        u32x4 w; w.x = cvtpk(v0[0], v0[1]); w.y = cvtpk(v0[2], v0[3]); w.z = cvtpk(v1[0], v1[1]); w.w = cvtpk(v1[2], v1[3]);
                        *(u32x4*)(xb + off) = w;
                        s += (v0[0] * v0[0] + v0[1] * v0[1]) + (v0[2] * v0[2] + v0[3] * v0[3]) + (v1[0] * v1[0] + v1[1] * v1[1]) + (v1[2] * v1[2] + v1[3] * v1[3]);
                    }
                }
                if (RM != 2) { s += __shfl_xor(s, 16); s += __shfl_xor(s, 32); if (fq == 0) ssq_out[(size_t)row * 16 + u.pn * 4 + wc] = s; }
            }
    }
};
struct EpiOut {
    bf16_t* O; int ldc; const float* ssq_in; float inv_dim; int hd_in, hd_out; float* ssq_o[4];
    __device__ __forceinline__ void operator()(const f32x4 (&acc)[2][2][4][2], const Unit& u, int wr, int wc, int fr, int fq) const {
        const int row0 = u.pm * BM + wr * 64 + fr, col0 = u.pn * BM + wc * 32 + 8 * fq;
        float* so = (u.pn == 0) ? ssq_o[0] : (u.pn == 1) ? ssq_o[1] : (u.pn == 2) ? ssq_o[2] : (u.pn == 3) ? ssq_o[3] : nullptr;
#pragma unroll
        for (int ai = 0; ai < 2; ++ai)
#pragma unroll
            for (int m = 0; m < 4; ++m) {
                const int row = row0 + ai * HALF + m * 16; float s = 0.f;
                const float rs = ssq_in ? 1.0f / sqrtf(ssq_sum(ssq_in + (size_t)row * 16) * inv_dim + EPS) : 1.0f;
#pragma unroll
                for (int bj = 0; bj < 2; ++bj) {
                    int col = col0 + bj * HALF; if (hd_in) col = (col / hd_in) * hd_out + (col % hd_in);
                    const f32x4 v0 = acc[ai][bj][m][0] * rs, v1 = acc[ai][bj][m][1] * rs;
                    u32x4 w; w.x = cvtpk(v0[0], v0[1]); w.y = cvtpk(v0[2], v0[3]); w.z = cvtpk(v1[0], v1[1]); w.w = cvtpk(v1[2], v1[3]);
                    *(u32x4*)(O + (size_t)row * ldc + col) = w;
                    s += (v0[0] * v0[0] + v0[1] * v0[1]) + (v0[2] * v0[2] + v0[3] * v0[3]) + (v1[0] * v1[0] + v1[1] * v1[1]) + (v1[2] * v1[2] + v1[3] * v1[3]);
                }
                if (so) { s += __shfl_xor(s, 16); s += __shfl_xor(s, 32); if (fq == 0) so[(size_t)row * 16 + (u.pn & 1) * 4 + wc] = s; }
            }
    }
};
struct EpiOutT {
    bf16_t* O; int ldc; const float* ssq_in; float inv_dim;
    __device__ __forceinline__ void operator()(const f32x4 (&acc)[2][2][4][2], const Unit& u, int wr, int wc, int fr, int fq) const {
        const int row0 = u.pm * BM + wr * 64 + fr, col0 = u.pn * BM + wc * 32 + 8 * fq;
        f32x4 cs[2][2];
#pragma unroll
        for (int bj = 0; bj < 2; ++bj)
#pragma unroll
            for (int n = 0; n < 2; ++n) {
#pragma unroll
                for (int e = 0; e < 4; ++e) cs[bj][n][e] = 1.0f / sqrtf(ssq_sum(ssq_in + (size_t)(col0 + bj * HALF + 4 * n + e) * 16) * inv_dim + EPS); }
#pragma unroll
        for (int ai = 0; ai < 2; ++ai)
#pragma unroll
            for (int m = 0; m < 4; ++m) {
                const int row = row0 + ai * HALF + m * 16;
#pragma unroll
                for (int bj = 0; bj < 2; ++bj) {
                    const f32x4 v0 = acc[ai][bj][m][0] * cs[bj][0], v1 = acc[ai][bj][m][1] * cs[bj][1];
                    u32x4 w; w.x = cvtpk(v0[0], v0[1]); w.y = cvtpk(v0[2], v0[3]); w.z = cvtpk(v1[0], v1[1]); w.w = cvtpk(v1[2], v1[3]);
                    *(u32x4*)(O + (size_t)row * ldc + col0 + bj * HALF) = w;
                }
            }
    }
};

struct EpiQK0 {
    bf16_t* O; const float* ssq_in; const float* gq; const float* gk; float qscale;
    __device__ __forceinline__ void operator()(const f32x4 (&acc)[2][2][4][2], const Unit& u, int wr, int wc, int fr, int fq) const {
        { const int l_ = lane_now(); fq = l_ >> 4; fr = l_ & 15; }
        const int row0 = u.pm * BM + wr * 64 + fr;
        if (u.pn >= 4) {
            const int col0 = u.pn * BM + wc * 32 + 8 * fq;
#pragma unroll
            for (int ai = 0; ai < 2; ++ai)
#pragma unroll
                for (int m = 0; m < 4; ++m) {
                    const int row = row0 + ai * HALF + m * 16;
                    const float rs = (u.pn < 6 ? qscale : 1.0f) / sqrtf(ssq_sum(ssq_in + (size_t)row * 16) * (1.0f / DM) + EPS);
#pragma unroll
                    for (int bj = 0; bj < 2; ++bj) {
                        const f32x4 v0 = acc[ai][bj][m][0] * rs, v1 = acc[ai][bj][m][1] * rs;
                        u32x4 w; w.x = cvtpk(v0[0], v0[1]); w.y = cvtpk(v0[2], v0[3]); w.z = cvtpk(v1[0], v1[1]); w.w = cvtpk(v1[2], v1[3]);
                        *(u32x4*)(O + (size_t)row * 2048 + col0 + bj * HALF) = w;
                    }
                }
            return;
        }
        const int head = u.pn * 4 + wc;
        const float* g = (head < 8 ? gq : gk) + 8 * fq;
        f32x4 gv[2][2];
#pragma unroll
        for (int bj = 0; bj < 2; ++bj)
#pragma unroll
            for (int n = 0; n < 2; ++n) gv[bj][n] = *(const f32x4*)(g + bj * 32 + 4 * n);
#pragma unroll
        for (int ai = 0; ai < 2; ++ai)
#pragma unroll
            for (int m = 0; m < 4; ++m) {
                const int row = row0 + ai * HALF + m * 16; const int pos = row & (SEQ - 1);
                float s = 0.f;
#pragma unroll
                for (int bj = 0; bj < 2; ++bj)
#pragma unroll
                    for (int n = 0; n < 2; ++n) { const f32x4 v = acc[ai][bj][m][n]; s += (v[0] * v[0] + v[1] * v[1]) + (v[2] * v[2] + v[3] * v[3]); }
                s += __shfl_xor(s, 16); s += __shfl_xor(s, 32);
                const float rx = 1.0f / sqrtf(ssq_sum(ssq_in + (size_t)row * 16) * (1.0f / DM) + EPS);
                const float rs = (head < 8 ? qscale : 1.0f) * rx / sqrtf(s * rx * rx * (1.0f / 64.0f) + EPS);
                float o1[8], o2[8];
#pragma unroll
                for (int n = 0; n < 2; ++n)
#pragma unroll
                    for (int e = 0; e < 4; ++e) {
                        float cs, sn; rope_cs(pos, 8 * fq + 4 * n + e, cs, sn);
                        const float x1 = acc[ai][0][m][n][e] * rs * gv[0][n][e], x2 = acc[ai][1][m][n][e] * rs * gv[1][n][e];
                        o1[4 * n + e] = x1 * cs - x2 * sn; o2[4 * n + e] = x1 * sn + x2 * cs;
                    }
                bf16_t* op = O + (size_t)row * 2048 + head * 64 + 8 * fq;
                u32x4 w; w.x = cvtpk(o1[0], o1[1]); w.y = cvtpk(o1[2], o1[3]); w.z = cvtpk(o1[4], o1[5]); w.w = cvtpk(o1[6], o1[7]);
                *(u32x4*)op = w;
                w.x = cvtpk(o2[0], o2[1]); w.y = cvtpk(o2[2], o2[3]); w.z = cvtpk(o2[4], o2[5]); w.w = cvtpk(o2[6], o2[7]);
                *(u32x4*)(op + 32) = w;
                asm volatile("" ::: "memory");
            }
    }
};
struct EpiK1 {
    bf16_t* O; const bf16_t* T1; const float* ssq_in; const float* gk;
    __device__ __forceinline__ void operator()(const f32x4 (&acc)[2][2][4][2], const Unit& u, int wr, int wc, int fr, int fq) const {
        { const int l_ = lane_now(); fq = l_ >> 4; fr = l_ & 15; }
        const int row0 = u.pm * BM + wr * 64 + fr;
        const int head = u.pn * 4 + wc;
        float rhs[8];
#pragma unroll
        for (int ai = 0; ai < 2; ++ai)
#pragma unroll
            for (int m = 0; m < 4; ++m) {
                const int row = row0 + ai * HALF + m * 16;
                const float rkv = 1.0f / sqrtf(ssq_sum(ssq_in + (size_t)row * 16) * (1.0f / 256.0f) + EPS);
                const u32x4 kw = *(const u32x4*)(T1 + (size_t)row * 1024 + 768 + 8 * fq);
                float s = (bflo(kw.x) * bflo(kw.x) + bfhi(kw.x) * bfhi(kw.x)) + (bflo(kw.y) * bflo(kw.y) + bfhi(kw.y) * bfhi(kw.y))
                        + (bflo(kw.z) * bflo(kw.z) + bfhi(kw.z) * bfhi(kw.z)) + (bflo(kw.w) * bflo(kw.w) + bfhi(kw.w) * bfhi(kw.w));
#pragma unroll
                for (int bj = 0; bj < 2; ++bj)
#pragma unroll
                    for (int n = 0; n < 2; ++n) { const f32x4 v = acc[ai][bj][m][n] * rkv; s += (v[0] * v[0] + v[1] * v[1]) + (v[2] * v[2] + v[3] * v[3]); }
                s += __shfl_xor(s, 16); s += __shfl_xor(s, 32);
                const float rh = 1.0f / sqrtf(s * (1.0f / 96.0f) + EPS), rs = rkv * rh;
                rhs[ai * 4 + m] = rh;
                bf16_t* op = O + (size_t)row * 1536 + head * 96;
#pragma unroll
                for (int bj = 0; bj < 2; ++bj) {
                    const f32x4 g0 = *(const f32x4*)(gk + bj * 32 + 8 * fq), g1 = *(const f32x4*)(gk + bj * 32 + 8 * fq + 4);
                    const f32x4 v0 = acc[ai][bj][m][0] * rs * g0, v1 = acc[ai][bj][m][1] * rs * g1;
                    u32x4 w; w.x = cvtpk(v0[0], v0[1]); w.y = cvtpk(v0[2], v0[3]); w.z = cvtpk(v1[0], v1[1]); w.w = cvtpk(v1[2], v1[3]);
                    *(u32x4*)(op + bj * 32 + 8 * fq) = w;
                }
                asm volatile("" ::: "memory");
            }
        const f32x4 gr0 = *(const f32x4*)(gk + 64 + 8 * fq), gr1 = *(const f32x4*)(gk + 64 + 8 * fq + 4);
#pragma unroll
        for (int ai = 0; ai < 2; ++ai)
#pragma unroll
            for (int m = 0; m < 4; ++m) {
                const int row = row0 + ai * HALF + m * 16; const int pos = row & (SEQ - 1);
                const float rh = rhs[ai * 4 + m];
                const u32x4 kw = *(const u32x4*)(T1 + (size_t)row * 1024 + 768 + 8 * fq);
                const float kr[8] = {bflo(kw.x), bfhi(kw.x), bflo(kw.y), bfhi(kw.y), bflo(kw.z), bfhi(kw.z), bflo(kw.w), bfhi(kw.w)};
                float ro[8];
#pragma unroll
                for (int j = 0; j < 8; ++j) {
                    const float x = kr[j] * rh * (j < 4 ? gr0[j & 3] : gr1[j & 3]);
                    const float px = __shfl_xor(x, 32);
                    float cs, sn; rope_cs(pos, 2 * (8 * (fq & 1) + j), cs, sn);
                    ro[j] = (fq < 2) ? (x * cs - px * sn) : (px * sn + x * cs);
                }
                u32x4 w; w.x = cvtpk(ro[0], ro[1]); w.y = cvtpk(ro[2], ro[3]); w.z = cvtpk(ro[4], ro[5]); w.w = cvtpk(ro[6], ro[7]);
                *(u32x4*)(O + (size_t)row * 1536 + head * 96 + 64 + 8 * fq) = w;
                asm volatile("" ::: "memory");
            }
    }
};
}

__device__ __forceinline__ void swap32(float x, float& lo, float& hi_) {
    auto rr = __builtin_amdgcn_permlane32_swap(__float_as_uint(x), __float_as_uint(x), false, false);
    lo = __uint_as_float(rr[0]); hi_ = __uint_as_float(rr[1]);
}
template <int DQK, int DV, int MODE, int QPRE, bool DIFF>
__device__ __forceinline__ void attn_unit(LAS unsigned char* lds, const bf16_t* __restrict__ Q, int ldq, const bf16_t* __restrict__ Kp0, int ldk,
                                          const bf16_t* __restrict__ VT, int ldvt, bf16_t* __restrict__ O, int ldo, int q0, int nkt, float c  ,
                                          const float* __restrict__ qg, const float* __restrict__ subln, float lam, float post, int wave_s) {
    constexpr int KST = DQK * 2 + 16, VST = 144, KBUF = 64 * KST, VBUF = DV * VST, BUF = KBUF + VBUF;
    constexpr int KCH = DQK / 8, NKC = 64 * KCH, NKL = (NKC + 511) / 512, NVC = DV * 8, NVL = NVC / 512, ND0 = DQK / 16, NDB = DV / 32;
    static_assert(BUF % 16 == 0 && (DV == 64 ? 4 : 2) * BUF <= 131072, "lds");
    const int lane = lane_now(), wid = wave_s, tid = wid * 64 + lane, l32 = lane & 31, hi = lane >> 5;
    LAS unsigned* o1l = (LAS unsigned*)(lds + 65536 + wid * 8192) + lane;
    static_assert(!DIFF || 2 * BUF <= 65536, "o1 park");
    const int my_last = (MODE == 2) ? (nkt - 1) : ((q0 + wid * 32) >> 6);
#pragma unroll 1
    for (int mp = 0; mp < (DIFF ? 2 : 1); ++mp) {
    const bf16_t* Kp = Kp0 + mp * 256;
    bf16x8 qf[ND0];
    { const bf16_t* qrow = Q + mp * 256 + (size_t)(q0 + wid * 32 + l32) * ldq + hi * 8;
#pragma unroll
      for (int d0 = 0; d0 < ND0; ++d0) qf[d0] = *(const bf16x8*)(qrow + d0 * 16); }
    if (QPRE != 0) {
        float v[ND0][8]; float s = 0.f;
#pragma unroll
        for (int d0 = 0; d0 < ND0; ++d0)
#pragma unroll
            for (int j = 0; j < 8; ++j) { v[d0][j] = bf2f((unsigned short)qf[d0][j]); s += v[d0][j] * v[d0][j]; }
        { float a, b; swap32(s, a, b); s = a + b; }
        const float rs = 1.0f / sqrtf(s * (1.0f / DQK) + EPS);
#pragma unroll
        for (int d0 = 0; d0 < ND0; ++d0) { const f32x4 g0 = *(const f32x4*)(qg + d0 * 16 + hi * 8), g1 = *(const f32x4*)(qg + d0 * 16 + hi * 8 + 4);
#pragma unroll
            for (int j = 0; j < 4; ++j) { v[d0][j] *= rs * c * g0[j]; v[d0][4 + j] *= rs * c * g1[j]; } }
        if (QPRE == 3) {
            const int pos = q0 + wid * 32 + l32;
#pragma unroll
            for (int j = 0; j < 8; ++j) { float cs, sn; rope_cs(pos, 2 * (8 * hi + j), cs, sn); const float x1 = v[ND0 - 2][j], x2 = v[ND0 - 1][j];
                v[ND0 - 2][j] = x1 * cs - x2 * sn; v[ND0 - 1][j] = x1 * sn + x2 * cs; }
        }
#pragma unroll
        for (int d0 = 0; d0 < ND0; ++d0) { u32x4 w; w.x = cvtpk(v[d0][0], v[d0][1]); w.y = cvtpk(v[d0][2], v[d0][3]); w.z = cvtpk(v[d0][4], v[d0][5]); w.w = cvtpk(v[d0][6], v[d0][7]); qf[d0] = __builtin_bit_cast(bf16x8, w); }
    }
    f32x16 o[NDB];
#pragma unroll
    for (int i = 0; i < NDB; ++i)
#pragma unroll
        for (int r = 0; r < 16; ++r) o[i][r] = 0.f;
    float mhat = 0.f, l_run = 0.f, Rp = 1.0f;
    bool sb_done = false;
    f32x16 negm;
#pragma unroll
    for (int r = 0; r < 16; ++r) negm[r] = 0.f;
    constexpr bool DEEP = (DV == 64);
    u32x4 kreg[DEEP ? 4 : 1][NKL], vreg[DEEP ? 4 : 1][NVL];
#define ATT_TILE(i) ((MODE == 1) ? (nkt - 1 - (i)) : (i))
    unsigned kof[NKL], vof[NVL];
#pragma unroll
    for (int j = 0; j < NKL; ++j) { const int ci = tid + 512 * j; const int row = ci / KCH, cc = ci % KCH; kof[j] = (unsigned)(row * ldk + cc * 8); }
#pragma unroll
    for (int j = 0; j < NVL; ++j) { const int ci = tid + 512 * j; const int d = ci >> 3, cc = ci & 7; vof[j] = (unsigned)(d * ldvt + cc * 8); }
#define ATT_LOADG(t, rs) do { const bf16_t* kt_ = Kp + (size_t)(t) * 64 * ldk; const bf16_t* vt_ = VT + (size_t)(t) * 64; \
    _Pragma("unroll") for (int j = 0; j < NKL; ++j) { const int ci = tid + 512 * j; if (NKC % 512 == 0 || ci < NKC) kreg[rs][j] = *(const u32x4*)(kt_ + kof[j]); } \
    _Pragma("unroll") for (int j = 0; j < NVL; ++j) vreg[rs][j] = *(const u32x4*)(vt_ + vof[j]); } while (0)
#define ATT_STORE(b, rs) do { LAS unsigned char* kb_ = lds + (b) * BUF; LAS unsigned char* vb_ = kb_ + KBUF; \
    _Pragma("unroll") for (int j = 0; j < NKL; ++j) { const int ci = tid + 512 * j; if (NKC % 512 == 0 || ci < NKC) { const int row = ci / KCH, cc = ci % KCH; \
        *(LAS u32x4*)(kb_ + row * KST + cc * 16) = kreg[rs][j]; } } \
    _Pragma("unroll") for (int j = 0; j < NVL; ++j) { const int ci = tid + 512 * j; const int d = ci >> 3, cc = ci & 7; \
        *(LAS u32x2*)(vb_ + d * VST + (cc >> 1) * 32 + (cc & 1) * 8) = (u32x2){vreg[rs][j].x, vreg[rs][j].y}; *(LAS u32x2*)(vb_ + d * VST + (cc >> 1) * 32 + (cc & 1) * 8 + 16) = (u32x2){vreg[rs][j].z, vreg[rs][j].w}; } } while (0)
#define ATT_BAR() do { asm volatile("s_waitcnt lgkmcnt(0)" ::: "memory"); __builtin_amdgcn_s_barrier(); asm volatile("" ::: "memory"); } while (0)
    ATT_LOADG(ATT_TILE(0), 0); if (DEEP) { ATT_LOADG(ATT_TILE(1), (DEEP ? 1 : 0)); ATT_LOADG(ATT_TILE(2), (DEEP ? 2 : 0)); ATT_LOADG(ATT_TILE(3), (DEEP ? 3 : 0)); }
    LAS unsigned* sbcnt = (LAS unsigned*)(lds + 131072 + 32);
    if (MODE == 1 && wid == 0 && lane == 0) *sbcnt = 0u;
    bool sb_stop = false;
    ATT_STORE(0, 0); if (DEEP) ATT_STORE(1, (DEEP ? 1 : 0)); ATT_BAR();
    int pp = 0;
    constexpr int UNR = DEEP ? 2 : 1;
    constexpr bool QKFIRST = (MODE == 1);
    constexpr int NPH = DEEP ? 2 : 1;
    for (int i00 = 0; i00 < nkt && !sb_stop; i00 += UNR * NPH) {
#pragma unroll
    for (int ph = 0; ph < NPH; ++ph) {
    const int i0 = i00 + UNR * ph;
    if (!(MODE == 1 && sb_stop)) {
    f32x16 sq[UNR][2];
#pragma unroll
    for (int hf = 0; hf < UNR; ++hf) {
        const int i = i0 + hf;
        const int bi = DEEP ? (pp * 2 + hf) : (i & 1);
        const int t = ATT_TILE(i);
        if (DEEP) { if (hf == 0 && i0 + 4 < nkt) { ATT_LOADG(ATT_TILE(i0 + 4), (DEEP ? 2 * ph : 0)); ATT_LOADG(ATT_TILE(i0 + 5), (DEEP ? 2 * ph + 1 : 0)); } } else { if (i + 1 < nkt) ATT_LOADG(ATT_TILE(i + 1), 0); }
        if (t <= my_last && !(MODE == 1 && sb_done)) {
            const LAS unsigned char* kb = lds + bi * BUF + l32 * KST + hi * 16;
            f32x16& s0 = sq[hf][0]; f32x16& s1 = sq[hf][1];
            if (QKFIRST) {
            {
                const bf16x8 a0 = *(const LAS bf16x8*)(kb), a1 = *(const LAS bf16x8*)(kb + 32 * KST);
                if (MODE == 1) { const f32x16 z16 = {0.f, 0.f, 0.f, 0.f, 0.f, 0.f, 0.f, 0.f, 0.f, 0.f, 0.f, 0.f, 0.f, 0.f, 0.f, 0.f};
                    s0 = __builtin_amdgcn_mfma_f32_32x32x16_bf16(a0, qf[0], z16, 0, 0, 0); s1 = __builtin_amdgcn_mfma_f32_32x32x16_bf16(a1, qf[0], z16, 0, 0, 0); }
                else { s0 = __builtin_amdgcn_mfma_f32_32x32x16_bf16(a0, qf[0], negm, 0, 0, 0); s1 = __builtin_amdgcn_mfma_f32_32x32x16_bf16(a1, qf[0], negm, 0, 0, 0); }
            }
#pragma unroll
            for (int d0 = 1; d0 < ND0; ++d0) {
                const bf16x8 a0 = *(const LAS bf16x8*)(kb + d0 * 32), a1 = *(const LAS bf16x8*)(kb + 32 * KST + d0 * 32);
                s0 = __builtin_amdgcn_mfma_f32_32x32x16_bf16(a0, qf[d0], s0, 0, 0, 0);
                s1 = __builtin_amdgcn_mfma_f32_32x32x16_bf16(a1, qf[d0], s1, 0, 0, 0);
            }
            }
        }
    }
#pragma unroll
    for (int hf = 0; hf < UNR; ++hf) {
        const int i = i0 + hf;
        const int bi = DEEP ? (pp * 2 + hf) : (i & 1);
        const int t = ATT_TILE(i);
        if (t <= my_last && !(MODE == 1 && sb_done)) {
            const LAS unsigned char* vb = lds + bi * BUF + KBUF + l32 * VST + hi * 16;
            f32x16& s0 = sq[hf][0]; f32x16& s1 = sq[hf][1];
            if (!QKFIRST) {
                const LAS unsigned char* kb = lds + bi * BUF + l32 * KST + hi * 16;
            {
                const bf16x8 a0 = *(const LAS bf16x8*)(kb), a1 = *(const LAS bf16x8*)(kb + 32 * KST);
                if (MODE == 1) { const f32x16 z16 = {0.f, 0.f, 0.f, 0.f, 0.f, 0.f, 0.f, 0.f, 0.f, 0.f, 0.f, 0.f, 0.f, 0.f, 0.f, 0.f};
                    s0 = __builtin_amdgcn_mfma_f32_32x32x16_bf16(a0, qf[0], z16, 0, 0, 0); s1 = __builtin_amdgcn_mfma_f32_32x32x16_bf16(a1, qf[0], z16, 0, 0, 0); }
                else { s0 = __builtin_amdgcn_mfma_f32_32x32x16_bf16(a0, qf[0], negm, 0, 0, 0); s1 = __builtin_amdgcn_mfma_f32_32x32x16_bf16(a1, qf[0], negm, 0, 0, 0); }
            }
#pragma unroll
            for (int d0 = 1; d0 < ND0; ++d0) {
                const bf16x8 a0 = *(const LAS bf16x8*)(kb + d0 * 32), a1 = *(const LAS bf16x8*)(kb + 32 * KST + d0 * 32);
                s0 = __builtin_amdgcn_mfma_f32_32x32x16_bf16(a0, qf[d0], s0, 0, 0, 0);
                s1 = __builtin_amdgcn_mfma_f32_32x32x16_bf16(a1, qf[d0], s1, 0, 0, 0);
            }
            }
            bf16x8 vf[2][4];
#define ATT_LOADV(dst, db_) do { const LAS unsigned char* vr_ = vb + (db_) * 32 * VST; _Pragma("unroll") for (int kk = 0; kk < 4; ++kk) dst[kk] = *(const LAS bf16x8*)(vr_ + kk * 32); } while (0)
            ATT_LOADV(vf[0], 0); if (!DEEP) ATT_LOADV(vf[1], 1);
            __builtin_amdgcn_sched_barrier(0);
            if (MODE != 1) {
                float mx = fmaxf(s0[0], s1[0]);
#pragma unroll
                for (int r = 1; r < 16; ++r) mx = fmaxf(fmaxf(mx, s0[r]), s1[r]);
                { float a, b; swap32(mx, a, b); mx = fmaxf(a, b); }
                const bool first = (i == 0);
                if (first || __any(mx > 8.0f)) {
                    const float dl = first ? mx : fmaxf(mx, 0.f);
                    mhat += dl;
#pragma unroll
                    for (int r = 0; r < 16; ++r) { s0[r] -= dl; s1[r] -= dl; negm[r] = -mhat; }
                    if (DEEP && QKFIRST && hf == 0 && (ATT_TILE(i0 + UNR - 1) <= my_last)) {
#pragma unroll
                        for (int r = 0; r < 16; ++r) { sq[UNR - 1][0][r] -= dl; sq[UNR - 1][1][r] -= dl; }
                    }
                    if (!first) {
                        const float alpha = __builtin_amdgcn_exp2f(-dl);
                        l_run *= alpha;
#pragma unroll
                        for (int i2 = 0; i2 < NDB; ++i2)
#pragma unroll
                            for (int r = 0; r < 16; ++r) o[i2][r] *= alpha;
                    }
                }
                float ls = 0.f;
#pragma unroll
                for (int r = 0; r < 16; ++r) { s0[r] = __builtin_amdgcn_exp2f(s0[r]); s1[r] = __builtin_amdgcn_exp2f(s1[r]); ls = fadd_s(ls, fadd_s(s0[r], s1[r])); }
                l_run += ls;
            } else {
                const bool diag = (t == my_last);
                const int qrel = q0 + wid * 32 + l32 - t * 64;
                float kp[32], gprod[8];
#pragma unroll
                for (int k = 0; k < 8; ++k) {
#pragma unroll
                    for (int e = 0; e < 4; ++e) {
                        const int r = (k & 3) * 4 + e;
                        const float z2 = __builtin_amdgcn_fmed3f((k < 4) ? s0[r] : s1[r], -126.0f, 126.0f);
                        const float E = __builtin_amdgcn_exp2f(z2);
                        const float keep = __builtin_amdgcn_rcpf(fadd_s(E, 1.0f)), beta = fmul_s(E, keep);
                        kp[k * 4 + e] = keep;
                        if (k < 4) s0[r] = beta; else s1[r] = beta;
                    }
                }
                if (diag) {
                    asm volatile("" ::: "memory");
#pragma unroll
                    for (int k = 0; k < 8; ++k)
#pragma unroll
                        for (int e = 0; e < 4; ++e) { const int r = (k & 3) * 4 + e; const int kl = (k >> 2) * 32 + e + 8 * (k & 3) + 4 * hi; const bool valid = kl < qrel;
                            kp[k * 4 + e] = valid ? kp[k * 4 + e] : 1.0f; if (k < 4) s0[r] = valid ? s0[r] : 0.f; else s1[r] = valid ? s1[r] : 0.f; }
                }
#pragma unroll
                for (int k = 0; k < 8; ++k) gprod[k] = fmul_s(fmul_s(kp[k * 4], kp[k * 4 + 1]), fmul_s(kp[k * 4 + 2], kp[k * 4 + 3]));
                float base[8]; float suf = 1.0f;
#pragma unroll
                for (int k = 7; k >= 0; --k) { float glo, ghi; swap32(gprod[k], glo, ghi); base[k] = fmul_s(fmul_s(Rp, suf), (hi == 0 ? ghi : 1.0f)); suf = fmul_s(suf, fmul_s(glo, ghi)); }
                Rp *= suf;
                { const bool nd = __all(Rp == 0.0f); if (nd && !sb_done && lane == 0) __hip_atomic_fetch_add(sbcnt, 1u, __ATOMIC_RELAXED, __HIP_MEMORY_SCOPE_WORKGROUP); sb_done = nd; }
#pragma unroll
                for (int k = 0; k < 8; ++k) {
                    const float l3 = base[k], l2 = fmul_s(l3, kp[k * 4 + 3]), l1 = fmul_s(l2, kp[k * 4 + 2]), l0 = fmul_s(l1, kp[k * 4 + 1]);
                    const int r = (k & 3) * 4;
                    if (k < 4) { s0[r] = fmul_s(s0[r], l0); s0[r + 1] = fmul_s(s0[r + 1], l1); s0[r + 2] = fmul_s(s0[r + 2], l2); s0[r + 3] = fmul_s(s0[r + 3], l3); }
                    else       { s1[r] = fmul_s(s1[r], l0); s1[r + 1] = fmul_s(s1[r + 1], l1); s1[r + 2] = fmul_s(s1[r + 2], l2); s1[r + 3] = fmul_s(s1[r + 3], l3); }
                }
            }
            bf16x8 pb[4];
#pragma unroll
            for (int kk = 0; kk < 4; ++kk) {
                u32x4 w;
                if (kk < 2) { const int b = kk * 8; w.x = cvtpk(s0[b], s0[b + 1]); w.y = cvtpk(s0[b + 2], s0[b + 3]); w.z = cvtpk(s0[b + 4], s0[b + 5]); w.w = cvtpk(s0[b + 6], s0[b + 7]); }
                else        { const int b = (kk - 2) * 8; w.x = cvtpk(s1[b], s1[b + 1]); w.y = cvtpk(s1[b + 2], s1[b + 3]); w.z = cvtpk(s1[b + 4], s1[b + 5]); w.w = cvtpk(s1[b + 6], s1[b + 7]); }
                pb[kk] = __builtin_bit_cast(bf16x8, w);
            }
            __builtin_amdgcn_sched_barrier(0);
#pragma unroll
            for (int dbp = 0; dbp < NDB; dbp += 2) {
                if (!DEEP) {
#pragma unroll
                    for (int kk = 0; kk < 4; ++kk) { o[dbp] = __builtin_amdgcn_mfma_f32_32x32x16_bf16(vf[0][kk], pb[kk], o[dbp], 0, 0, 0);
                                                     o[dbp + 1] = __builtin_amdgcn_mfma_f32_32x32x16_bf16(vf[1][kk], pb[kk], o[dbp + 1], 0, 0, 0); }
                } else {
#pragma unroll
                    for (int kk = 0; kk < 4; ++kk) o[dbp] = __builtin_amdgcn_mfma_f32_32x32x16_bf16(vf[0][kk], pb[kk], o[dbp], 0, 0, 0);
                    ATT_LOADV(vf[0], dbp + 1);
#pragma unroll
                    for (int kk = 0; kk < 4; ++kk) o[dbp + 1] = __builtin_amdgcn_mfma_f32_32x32x16_bf16(vf[0][kk], pb[kk], o[dbp + 1], 0, 0, 0);
                }
                if (dbp + 2 < NDB) { ATT_LOADV(vf[0], dbp + 2); ATT_LOADV(vf[1], dbp + 3); }
            }
#undef ATT_LOADV
        }
        if (DEEP) { if (hf == 1) { if (i0 + 2 < nkt) { ATT_STORE((pp ^ 1) * 2, (DEEP ? 2 * (ph ^ 1) : 0)); ATT_STORE((pp ^ 1) * 2 + 1, (DEEP ? 2 * (ph ^ 1) + 1 : 0)); } ATT_BAR(); pp ^= 1;
            if (MODE == 1) { sb_stop = (__builtin_amdgcn_readfirstlane((int)*(volatile LAS unsigned*)sbcnt) >= 8); ATT_BAR(); } } }
        else { if (i + 1 < nkt) ATT_STORE(bi ^ 1, 0); ATT_BAR(); }
    }
    }
    }
    }
    float inv = 1.0f;
    if (MODE != 1) { float a, b; swap32(l_run, a, b); inv = 1.0f / (a + b); }
    if (DIFF && mp == 0) {
#pragma unroll
        for (int db = 0; db < NDB; ++db)
#pragma unroll
            for (int g = 0; g < 8; ++g) o1l[(db * 8 + g) * 64] = cvtpk(o[db][2 * g] * inv, o[db][2 * g + 1] * inv);
        continue;
    }
    bf16_t* orow = O + (size_t)(q0 + wid * 32 + l32) * ldo + 4 * hi;
    if (DIFF) {
        float s = 0.f;
#pragma unroll
        for (int db = 0; db < NDB; ++db)
#pragma unroll
            for (int g = 0; g < 8; ++g) { const unsigned w = o1l[(db * 8 + g) * 64];
                const float a = bflo(w) - lam * (o[db][2 * g] * inv), b = bfhi(w) - lam * (o[db][2 * g + 1] * inv);
                o[db][2 * g] = a; o[db][2 * g + 1] = b; s += a * a + b * b; if (g == 7) asm volatile("" ::: "memory"); }
        { float a, b; swap32(s, a, b); s = a + b; }
        const float rs = post / sqrtf(s * (1.0f / DV) + EPS);
#pragma unroll
        for (int db = 0; db < NDB; ++db)
#pragma unroll
            for (int g = 0; g < 4; ++g) { const f32x4 gn = *(const f32x4*)(subln + db * 32 + 8 * g + 4 * hi);
                u32x2 w; w.x = cvtpk(o[db][4 * g] * rs * gn[0], o[db][4 * g + 1] * rs * gn[1]); w.y = cvtpk(o[db][4 * g + 2] * rs * gn[2], o[db][4 * g + 3] * rs * gn[3]);
                *(u32x2*)(orow + db * 32 + 8 * g) = w; }
    } else {
#pragma unroll
        for (int db = 0; db < NDB; ++db)
#pragma unroll
            for (int g = 0; g < 4; ++g) {
                u32x2 w; w.x = cvtpk(o[db][4 * g] * inv, o[db][4 * g + 1] * inv); w.y = cvtpk(o[db][4 * g + 2] * inv, o[db][4 * g + 3] * inv);
                *(u32x2*)(orow + db * 32 + 8 * g) = w;
            }
    }
    }
#undef ATT_TILE
#undef ATT_LOADG
#undef ATT_STORE
#undef ATT_BAR
}

constexpr size_t MiB = 1u << 20;
constexpr int SSQ_MQ = 8, SSQ_MKV = 9, SSQ_MEM = 10, NSSQ = 11;
constexpr size_t WS_BAR = 1792 * 1024, BAR_BYTES = 16384;
constexpr size_t WS_KMEM = 2 * MiB;
constexpr size_t WS_VTMEM = 6 * MiB;
constexpr size_t WS_MEMB = 10 * MiB;
constexpr size_t WS_W = 16 * MiB;
constexpr size_t SZ_WGU = (size_t)2 * DFF * DM * 2, SZ_WD = (size_t)DM * DFF * 2, SZ_FFN = SZ_WGU + SZ_WD;
constexpr size_t WS_FFN = WS_W;
constexpr size_t WS_WQK0 = WS_FFN + 4 * SZ_FFN;
constexpr size_t WS_WV0 = WS_WQK0 + 4 * MiB;
constexpr size_t WS_WOUT0 = WS_WV0 + 2 * MiB;
constexpr size_t WS_WD1 = WS_WOUT0 + 2 * MiB;
constexpr size_t WS_WUQ = WS_WD1 + 2 * MiB;
constexpr size_t WS_WUKVK = WS_WUQ + 3 * MiB / 2;
constexpr size_t WS_WUKVV = WS_WUKVK + MiB / 2;
constexpr size_t WS_WO1 = WS_WUKVV + MiB / 2;
constexpr size_t WS_XM = WS_WO1 + 2 * MiB;
constexpr size_t WS_XB = 105 * MiB;
static_assert(WS_XM + 8 * MiB <= WS_XB, "weights");
constexpr size_t WS_R1 = 170 * MiB;
constexpr size_t WS_H = WS_R1;
constexpr size_t WS_QK0 = WS_R1;
constexpr size_t WS_VT0 = WS_R1 + 128 * MiB;
constexpr size_t WS_OD0 = WS_R1 + 192 * MiB;
constexpr size_t WS_MIX0 = WS_R1 + 256 * MiB;
constexpr size_t WS_T1 = WS_R1;
constexpr size_t WS_Q1 = WS_R1 + 64 * MiB;
constexpr size_t WS_K1 = WS_R1 + 160 * MiB;
constexpr size_t WS_VT1 = WS_R1 + 256 * MiB;
constexpr size_t WS_O1 = WS_R1;
constexpr size_t WS_XQ = WS_R1;
constexpr size_t WS_XO = WS_R1 + 32 * MiB;
constexpr size_t WS_SSQ = WS_R1 + 320 * MiB;
constexpr size_t WS_END = WS_SSQ + (size_t)NSSQ * MTOK * 16 * 4;
static_assert(WS_END <= 512 * MiB && WS_XB + (size_t)MTOK * DM * 2 <= WS_R1, "ws map");

struct Params { const float* in[32]; float* out; unsigned char* ws; int lo, hi; };

__device__ __forceinline__ float wave_sum(float v) {
#pragma unroll
    for (int o = 1; o < 64; o <<= 1) v += __shfl_xor(v, o);
    return v;
}
__device__ __forceinline__ void prep_decode(int it, int nblk, int mode, bf16_t* d0, bf16_t* d1, int& k0, int& j0, bf16_t*& dst, int& row0) {
    const int kb = it / nblk, nb = it % nblk; k0 = 64 * kb; j0 = 32 * nb;
    dst = d0; row0 = j0;
    switch (mode) {
        case 1: row0 = (j0 >> 7) * 256 + (j0 & 127); break;
        case 2: row0 = (j0 >> 7) * 256 + 128 + (j0 & 127); break;
        case 3: { const int seg = j0 >> 9, r = j0 & 511; if (seg <= 1) { const int hd = j0 >> 6, dd = j0 & 63; row0 = (hd >> 2) * 256 + (dd >> 5) * 128 + (hd & 3) * 32; } else if (seg == 2) { dst = d1; row0 = r; } else if (seg == 3) row0 = 1024 + r; else if (seg == 4) row0 = 1536 + r; else { dst = d1; row0 = 512 + r; } } break;
        case 4: { const int h = j0 >> 7, w = j0 & 127; if (w < 64) row0 = (h >> 2) * 256 + (w >> 5) * 128 + (h & 3) * 32; else { dst = d1; row0 = h * 64 + w - 64; } } break;
        case 5: if (j0 >= 512) { dst = d1; row0 = j0 - 512; } break;
        case 6: row0 = 512 + j0; break;
        default: break;
    }
}
__device__ __forceinline__ void prep_job(const float* __restrict__ W, int Ns, int K, const float* __restrict__ gain, int mode, bf16_t* d0, bf16_t* d1,
                                         LAS float* scr, int gw, int NGW, int lane) {
    const int nblk = Ns / 32, nitems = (K / 64) * nblk;
    const int lr = lane >> 3, lc = (lane & 7) * 4;
    f32x4 ld[8]; float gg[8];
    int it = gw;
#define PREP_LOAD(it_) do { int k0_, j0_, r0_; bf16_t* ds_; prep_decode((it_), nblk, mode, d0, d1, k0_, j0_, ds_, r0_); \
        _Pragma("unroll") for (int i = 0; i < 8; ++i) { const int kk = i * 8 + lr; ld[i] = *(const f32x4*)(W + (size_t)(k0_ + kk) * Ns + j0_ + lc); gg[i] = gain ? gain[k0_ + kk] : 1.0f; } } while (0)
    if (it < nitems) PREP_LOAD(it);
    while (it < nitems) {
        int k0, j0, row0; bf16_t* dst; prep_decode(it, nblk, mode, d0, d1, k0, j0, dst, row0);
#pragma unroll
        for (int i = 0; i < 8; ++i) { const int kk = i * 8 + lr;
#pragma unroll
            for (int e = 0; e < 4; ++e) scr[kk * 33 + lc + e] = ld[i][e] * gg[i]; }
        const int itn = it + NGW;
        if (itn < nitems) PREP_LOAD(itn);
        asm volatile("s_waitcnt lgkmcnt(0)" ::: "memory");
        const int cch = lane & 7;
#pragma unroll
        for (int j = 0; j < 4; ++j) { const int n = (lane >> 3) + 8 * j; const LAS float* s = scr + (8 * cch) * 33 + n;
            u32x4 o; o.x = cvtpk(s[0 * 33], s[1 * 33]); o.y = cvtpk(s[2 * 33], s[3 * 33]); o.z = cvtpk(s[4 * 33], s[5 * 33]); o.w = cvtpk(s[6 * 33], s[7 * 33]);
            *(u32x4*)(dst + (size_t)(row0 + n) * K + k0 + 8 * cch) = o; }
        asm volatile("s_waitcnt lgkmcnt(0)" ::: "memory");
        it = itn;
    }
#undef PREP_LOAD
}
constexpr int PT_W = 0, PT_G = 256, PT_D0 = 512, PT_D1 = 768, PT_NS = 1024, PT_K = 1152, PT_MODE = 1280, PT_START = 1408;
__device__ __forceinline__ int rfl(int v) { return __builtin_amdgcn_readfirstlane(v); }
__device__ __forceinline__ unsigned long long rfl64(unsigned long long v) { return ((unsigned long long)(unsigned)rfl((int)(v >> 32)) << 32) | (unsigned)rfl((int)(unsigned)v); }
__device__ __forceinline__ void prep_addjob(LAS unsigned char* tb, int& nj, int& acc, const float* W, int Ns, int K, const float* gain, int mode, bf16_t* d0, bf16_t* d1) {
    ((LAS unsigned long long*)(tb + PT_W))[nj] = (unsigned long long)W; ((LAS unsigned long long*)(tb + PT_G))[nj] = (unsigned long long)gain;
    ((LAS unsigned long long*)(tb + PT_D0))[nj] = (unsigned long long)d0; ((LAS unsigned long long*)(tb + PT_D1))[nj] = (unsigned long long)d1;
    ((LAS int*)(tb + PT_NS))[nj] = Ns; ((LAS int*)(tb + PT_K))[nj] = K; ((LAS int*)(tb + PT_MODE))[nj] = mode; ((LAS int*)(tb + PT_START))[nj] = acc;
    acc += (K / 64) * (Ns / 32); ++nj; ((LAS int*)(tb + PT_START))[nj] = acc;
}
__device__ __forceinline__ void prep_all(LAS unsigned char* tb, int njobs, LAS float* scr, int gw, int NGW, int lane) {
    LAS int* tStart = (LAS int*)(tb + PT_START);
    const int total = rfl(tStart[njobs]);
    const int lr = lane >> 3, lc = (lane & 7) * 4;
    f32x4 ld[8]; float gg[8];
    int j = 0, k0n = 0, row0n = 0, Kn = 0; bf16_t* dstn = nullptr;
#define PREP_LOAD(it_) do { while ((it_) >= rfl(tStart[j + 1])) ++j; \
        const int loc_ = (it_) - rfl(tStart[j]); const int Ns_ = rfl(((LAS int*)(tb + PT_NS))[j]); Kn = rfl(((LAS int*)(tb + PT_K))[j]); const int mode_ = rfl(((LAS int*)(tb + PT_MODE))[j]); \
        const float* W_ = (const float*)rfl64(((LAS unsigned long long*)(tb + PT_W))[j]); const float* g_ = (const float*)rfl64(((LAS unsigned long long*)(tb + PT_G))[j]); \
        bf16_t* d0_ = (bf16_t*)rfl64(((LAS unsigned long long*)(tb + PT_D0))[j]); bf16_t* d1_ = (bf16_t*)rfl64(((LAS unsigned long long*)(tb + PT_D1))[j]); \
        int j0_; prep_decode(loc_, Ns_ / 32, mode_, d0_, d1_, k0n, j0_, dstn, row0n); \
        _Pragma("unroll") for (int i = 0; i < 8; ++i) { const int kk = i * 8 + lr; ld[i] = *(const f32x4*)(W_ + (size_t)(k0n + kk) * Ns_ + j0_ + lc); gg[i] = g_ ? g_[k0n + kk] : 1.0f; } } while (0)
    int it = gw;
    if (it < total) PREP_LOAD(it);
    while (it < total) {
        const int k0 = k0n, row0 = row0n, K = Kn; bf16_t* dst = dstn;
#pragma unroll
        for (int i = 0; i < 8; ++i) { const int kk = i * 8 + lr;
#pragma unroll
            for (int e = 0; e < 4; ++e) scr[kk * 33 + lc + e] = ld[i][e] * gg[i]; }
        const int itn = it + NGW;
        if (itn < total) PREP_LOAD(itn);
        asm volatile("s_waitcnt lgkmcnt(0)" ::: "memory");
        const int cch = lane & 7;
#pragma unroll
        for (int jj = 0; jj < 4; ++jj) { const int n = (lane >> 3) + 8 * jj; const LAS float* sp = scr + (8 * cch) * 33 + n;
            u32x4 o; o.x = cvtpk(sp[0 * 33], sp[1 * 33]); o.y = cvtpk(sp[2 * 33], sp[3 * 33]); o.z = cvtpk(sp[4 * 33], sp[5 * 33]); o.w = cvtpk(sp[6 * 33], sp[7 * 33]);
            *(u32x4*)(dst + (size_t)(row0 + n) * K + k0 + 8 * cch) = o; }
        asm volatile("s_waitcnt lgkmcnt(0)" ::: "memory");
        it = itn;
    }
#undef PREP_LOAD
}
__device__ __forceinline__ void row_to_bf16(const float* xrow, bf16_t* orow, float* ssq, int lane) {
    const f32x4* xr = (const f32x4*)xrow + lane; float s = 0.f;
    unsigned long long* o8 = (unsigned long long*)orow + lane;
#pragma unroll
    for (int j = 0; j < 4; ++j) { const f32x4 v = xr[64 * j]; s += (v[0] * v[0] + v[1] * v[1]) + (v[2] * v[2] + v[3] * v[3]);
        o8[64 * j] = (unsigned long long)cvtpk(v[0], v[1]) | ((unsigned long long)cvtpk(v[2], v[3]) << 32); }
    s = wave_sum(s);
    if (lane < 16) ssq[lane] = (lane == 0) ? s : 0.f;
}

__device__ __forceinline__ void ld8(const bf16_t* p, float (&v)[8]) { const u32x4 w = *(const u32x4*)p; v[0] = bflo(w.x); v[1] = bfhi(w.x); v[2] = bflo(w.y); v[3] = bfhi(w.y); v[4] = bflo(w.z); v[5] = bfhi(w.z); v[6] = bflo(w.w); v[7] = bfhi(w.w); }
__device__ __forceinline__ void st8(bf16_t* p, const float (&v)[8]) { u32x4 w; w.x = cvtpk(v[0], v[1]); w.y = cvtpk(v[2], v[3]); w.z = cvtpk(v[4], v[5]); w.w = cvtpk(v[6], v[7]); *(u32x4*)p = w; }

__device__ __forceinline__ void pp_l0(bf16_t* QK, const float* gq, const float* gk, int gw, int NGW, int lane) {
    const int sub = lane >> 3, j = lane & 7;
    for (int it = gw; it < MTOK * 2; it += NGW) {
        const int tok = it >> 1, hv = (it & 1) * 8 + sub;
        bf16_t* p = QK + (size_t)tok * 2048 + hv * 64 + j * 8;
        float v[8]; ld8(p, v);
        float s = 0.f;
#pragma unroll
        for (int e = 0; e < 8; ++e) s += v[e] * v[e];
        s += __shfl_xor(s, 1); s += __shfl_xor(s, 2); s += __shfl_xor(s, 4);
        const float rs = 1.0f / sqrtf(s * (1.0f / 64.0f) + EPS);
        const float* g = (hv < 8 ? gq : gk) + j * 8;
#pragma unroll
        for (int e = 0; e < 8; ++e) v[e] = v[e] * rs * g[e];
        const int pos = tok & (SEQ - 1);
        float o[8];
#pragma unroll
        for (int e = 0; e < 8; ++e) {
            const float pv = __shfl_xor(v[e], 4);
            float cs, sn; rope_cs(pos, (j & 3) * 8 + e, cs, sn);
            o[e] = (j < 4) ? (v[e] * cs - pv * sn) : (pv * sn + v[e] * cs);
        }
        st8(p, o);
    }
}
__device__ __forceinline__ void pp_norm128(bf16_t* X, int nvec, const float* g, int gw, int NGW, int lane) {
    const int sub = lane >> 4, j = lane & 15;
    for (int it = gw; it < nvec / 4; it += NGW) {
        bf16_t* p = X + (size_t)(it * 4 + sub) * 128 + j * 8;
        float v[8]; ld8(p, v);
        float s = 0.f;
#pragma unroll
        for (int e = 0; e < 8; ++e) s += v[e] * v[e];
        s += __shfl_xor(s, 1); s += __shfl_xor(s, 2); s += __shfl_xor(s, 4); s += __shfl_xor(s, 8);
        const float rs = 1.0f / sqrtf(s * (1.0f / 128.0f) + EPS);
#pragma unroll
        for (int e = 0; e < 8; ++e) v[e] = v[e] * rs * g[j * 8 + e];
        st8(p, v);
    }
}
__device__ __forceinline__ void pp_combine(const bf16_t* OD, bf16_t* MIX, const float* subln, float lam, float post, int gw, int NGW, int lane) {
    const int sub = lane >> 4, j = lane & 15;
    for (int it = gw; it < MTOK; it += NGW) {
        const bf16_t* p1 = OD + (size_t)it * 1024 + sub * 128 + j * 8;
        float a[8], b[8]; ld8(p1, a); ld8(p1 + 512, b);
        float s = 0.f;
#pragma unroll
        for (int e = 0; e < 8; ++e) { a[e] = a[e] - lam * b[e]; s += a[e] * a[e]; }
        s += __shfl_xor(s, 1); s += __shfl_xor(s, 2); s += __shfl_xor(s, 4); s += __shfl_xor(s, 8);
        const float rs = post / sqrtf(s * (1.0f / 128.0f) + EPS);
#pragma unroll
        for (int e = 0; e < 8; ++e) a[e] = a[e] * rs * subln[j * 8 + e];
        st8(MIX + (size_t)it * 1024 + sub * 128 + j * 8, a);
    }
}
__device__ __forceinline__ void pp_mla(bf16_t* X  , const bf16_t* T1, const float* g, bool isk, int gw, int NGW, int lane) {
    const int sub = lane >> 4, j = lane & 15;
    for (int it = gw; it < MTOK * 4; it += NGW) {
        const int tok = it >> 2, h = (it & 3) * 4 + sub;
        bf16_t* p = X + (size_t)tok * 1536 + h * 96 + j * 8;
        float v[8];
#pragma unroll
        for (int e = 0; e < 8; ++e) v[e] = 0.f;
        if (j < 12) { if (isk && j >= 8) ld8(T1 + (size_t)tok * 1024 + 768 + (j - 8) * 8, v); else ld8(p, v); }
        float s = 0.f;
#pragma unroll
        for (int e = 0; e < 8; ++e) s += v[e] * v[e];
        s += __shfl_xor(s, 1); s += __shfl_xor(s, 2); s += __shfl_xor(s, 4); s += __shfl_xor(s, 8);
        const float rs = 1.0f / sqrtf(s * (1.0f / 96.0f) + EPS);
        const int jj = j < 12 ? j : 0;
#pragma unroll
        for (int e = 0; e < 8; ++e) v[e] = v[e] * rs * g[jj * 8 + e];
        const int pos = tok & (SEQ - 1);
        float o[8];
#pragma unroll
        for (int e = 0; e < 8; ++e) {
            const float pv = __shfl_xor(v[e], 2);
            o[e] = v[e];
            if (j >= 8) { float cs, sn; rope_cs(pos, 2 * ((j & 1) * 8 + e), cs, sn); o[e] = (j < 10) ? (v[e] * cs - pv * sn) : (pv * sn + v[e] * cs); }
        }
        if (j < 12) st8(p, o);
    }
}


#define XB_TMO      128
#define XB_XCNT(j)  (256  + 64 * (j))
#define XB_XSUB(j)  (1280 + 64 * (j))
#define XB_XGEN(j)  (2304 + 64 * (j))
#define XB_TOP      3328
#define XB_TOPGEN   3392
#define XCD_BAR_WORDS 3456
#define XB_SPIN_CAP (1u << 18)
__device__ __forceinline__ unsigned xb_ld(unsigned* p)              { return __hip_atomic_load(p, __ATOMIC_RELAXED, __HIP_MEMORY_SCOPE_AGENT); }
__device__ __forceinline__ unsigned xb_add(unsigned* p, unsigned v) { return __hip_atomic_fetch_add(p, v, __ATOMIC_RELAXED, __HIP_MEMORY_SCOPE_AGENT); }
__device__ __forceinline__ unsigned xb_xcc_id() { return (unsigned)__builtin_amdgcn_s_getreg((3 << 11) | 20) & 0xFu; }
#define XB_SPIN(cond, bar) do { unsigned _sp = 0; while (cond) { __builtin_amdgcn_s_sleep(1); \
    if ((++_sp & 255u) == 0u) { if (xb_ld(&(bar)[XB_TMO])) break; if (_sp > XB_SPIN_CAP) { atomicAdd(&(bar)[XB_TMO], 1u); break; } } } } while (0)
struct XcdBarrier { unsigned* bar; unsigned x; volatile LAS unsigned* st; int wave; };
__device__ __forceinline__ XcdBarrier xcd_barrier_post(unsigned* bar, volatile LAS unsigned* st, int wave_s) {
    XcdBarrier b; b.bar = bar; b.x = xb_xcc_id(); b.st = st; b.wave = wave_s;
    if (wave_s == 0 && lane_now() == 0) (void)xb_add(&bar[XB_XCNT(b.x)], 1u);
    return b;
}
__device__ __forceinline__ void xcd_barrier_complete(unsigned* bar, unsigned x, unsigned& nloc, unsigned& nx) {
    const unsigned G = gridDim.x * gridDim.y * gridDim.z;
    unsigned sum, cnt, mine, sp = 0u;
    for (;;) {
        sum = 0u; cnt = 0u; mine = 0u;
#pragma unroll
        for (unsigned j = 0; j < 16; ++j) { const unsigned c = xb_ld(&bar[XB_XCNT(j)]); sum += c; cnt += (c > 0u) ? 1u : 0u; mine = (j == x) ? c : mine; }
        if (sum == G) break;
        __builtin_amdgcn_s_sleep(1);
        if ((++sp & 255u) == 0u) { if (xb_ld(&bar[XB_TMO])) break; if (sp > XB_SPIN_CAP) { atomicAdd(&bar[XB_TMO], 1u); break; } }
    }
    nloc = mine > 0u ? mine : 1u; nx = cnt > 0u ? cnt : 1u;
}
__device__ __forceinline__ void xcd_barrier(const XcdBarrier& b) {
    asm volatile("s_waitcnt vmcnt(0)" ::: "memory");
    __syncthreads();
    if (b.wave == 0 && lane_now() == 0) {
        unsigned* bar = b.bar;
        __builtin_amdgcn_s_waitcnt(0);
        unsigned nloc = b.st[0], nx = b.st[1];
        if (nloc == 0u) { xcd_barrier_complete(bar, b.x, nloc, nx); b.st[0] = nloc; b.st[1] = nx; }
        const unsigned old = xb_add(&bar[XB_XSUB(b.x)], 1u);
        const unsigned gen = old / nloc;
        if (old + 1u == (gen + 1u) * nloc) {
            __builtin_amdgcn_fence(__ATOMIC_RELEASE, "agent");
            asm volatile("s_waitcnt vmcnt(0)" ::: "memory");
            const unsigned og = xb_add(&bar[XB_TOP], 1u);
            const unsigned tg = og / nx;
            if (og + 1u == (tg + 1u) * nx) xb_add(&bar[XB_TOPGEN], 1u);
            else XB_SPIN(xb_ld(&bar[XB_TOPGEN]) == tg, bar);
            __builtin_amdgcn_fence(__ATOMIC_ACQUIRE, "agent");
            xb_add(&bar[XB_XGEN(b.x)], 1u);
            asm volatile("s_waitcnt vmcnt(0)" ::: "memory");
        } else {
            XB_SPIN(xb_ld(&bar[XB_XGEN(b.x)]) == gen, bar);
            __builtin_amdgcn_fence(__ATOMIC_ACQUIRE, "agent");
            asm volatile("s_waitcnt vmcnt(0)" ::: "memory");
        }
    }
    __syncthreads();
}

#ifndef REP_ATT
#define REP_ATT 1
#endif
#ifndef REP_G1
#define REP_G1 1
#endif
#ifndef EXTRA_SYNC
#define EXTRA_SYNC 0
#endif
constexpr int LDS_BYTES = 135168;
__global__ void __launch_bounds__(512, 2) fwd_kernel(Params P) {
    extern __shared__ __attribute__((aligned(16))) unsigned char lds_raw[];
    LAS unsigned char* lds = (LAS unsigned char*)lds_raw;
    cg::grid_group grid = cg::this_grid();
    const int G = gridDim.x, bid = blockIdx.x, NGW = G * 8;
    float* xout = P.out;
    int ph = 0;
    const int wave_s = __builtin_amdgcn_readfirstlane((int)(threadIdx.x >> 6));
    if (threadIdx.x < 4) ((LAS unsigned*)(lds + 131072))[threadIdx.x] = 0u;
    __syncthreads();
    XcdBarrier bar = xcd_barrier_post((unsigned*)(P.ws + WS_BAR), (volatile LAS unsigned*)(lds + 131072), wave_s);
    if (P.lo < 0) grid.sync();
#define SSQ(i) (ssq + (size_t)(i) * MTOK * 16)
#define IN(k) P.in[(k) + z_]
#define PHASE_BEGIN if (ph >= P.lo && ph < P.hi) { const int tid = wave_s * 64 + lane_now(); int z_; asm volatile("s_mov_b32 %0, 0" : "=s"(z_)); \
    const int lane = tid & 63, wave = wave_s, gw = bid * 8 + wave; unsigned char* ws = P.ws + z_; float* ssq = (float*)(ws + WS_SSQ); \
    bf16_t* xb = (bf16_t*)(ws + WS_XB); bf16_t* memb = (bf16_t*)(ws + WS_MEMB); (void)lane; (void)gw; (void)memb; (void)xb; (void)ssq;
#define PHASE_END   } if (ph >= P.lo && ph + 1 < P.hi) { xcd_barrier(bar); for (int es_ = 0; es_ < EXTRA_SYNC; ++es_) xcd_barrier(bar); } ++ph;

    PHASE_BEGIN
    {
        LAS float* scr = (LAS float*)(lds + wave * 16384);
        for (size_t i = (size_t)bid * 512 + tid; i < (size_t)2 * MTOK * 16; i += (size_t)G * 512) SSQ(SSQ_MQ)[i] = 0.f;
        LAS unsigned char* tb = lds + 131072 + 64;
        if (wave == 0 && lane == 0) {
            int nj = 0, acc = 0;
            for (int l = 0; l < 2; ++l)
                for (int j = 0; j < 2; ++j) {
                    const int f = l * 2 + j;
                    bf16_t* wgu = (bf16_t*)(ws + WS_FFN + f * SZ_FFN); bf16_t* wd = (bf16_t*)(ws + WS_FFN + f * SZ_FFN + SZ_WGU);
                    const float* gn = IN(2) + (size_t)f * DM;
                    prep_addjob(tb, nj, acc, IN(3) + (size_t)f * DM * DFF, DFF, DM, gn, 1, wgu, nullptr);
                    prep_addjob(tb, nj, acc, IN(4) + (size_t)f * DM * DFF, DFF, DM, gn, 2, wgu, nullptr);
                    prep_addjob(tb, nj, acc, IN(5) + (size_t)f * DFF * DM, DM, DFF, nullptr, 0, wd, nullptr);
                }
            prep_addjob(tb, nj, acc, IN(7), 3072, DM, IN(6), 3, (bf16_t*)(ws + WS_WQK0), (bf16_t*)(ws + WS_WV0));
            prep_addjob(tb, nj, acc, IN(8), DM, DM, nullptr, 0, (bf16_t*)(ws + WS_WOUT0), nullptr);
            prep_addjob(tb, nj, acc, IN(16), 512, DM, IN(6) + DM, 0, (bf16_t*)(ws + WS_WD1), nullptr);
            prep_addjob(tb, nj, acc, IN(19), 288, DM, IN(6) + DM, 6, (bf16_t*)(ws + WS_WD1), nullptr);
            prep_addjob(tb, nj, acc, IN(18), 1536, 512, IN(17), 0, (bf16_t*)(ws + WS_WUQ), nullptr);
            prep_addjob(tb, nj, acc, IN(21), 2048, 256, IN(20), 4, (bf16_t*)(ws + WS_WUKVK), (bf16_t*)(ws + WS_WUKVV));
            prep_addjob(tb, nj, acc, IN(24), DM, DM, nullptr, 0, (bf16_t*)(ws + WS_WO1), nullptr);
            for (int l = 0; l < 2; ++l) {
                bf16_t* base = (bf16_t*)(ws + WS_XM + l * 4 * MiB);
                prep_addjob(tb, nj, acc, IN(27) + (size_t)l * DM * 512, 512, DM, IN(25) + l * DM, 0, base, nullptr);
                prep_addjob(tb, nj, acc, IN(28) + (size_t)l * DM * 1024, 1024, DM, IN(26) + l * DM, 5, base + 512 * 1024, base + 2 * 512 * 1024);
                prep_addjob(tb, nj, acc, IN(31) + (size_t)l * 512 * DM, DM, 512, nullptr, 0, base + 3 * 512 * 1024, nullptr);
            }
        }
        __syncthreads();
        prep_all(tb, 25, scr, gw, NGW, lane);
        for (int m = gw; m < MTOK; m += 4 * NGW) {
            f32x4 v[4][4];
#pragma unroll
            for (int q = 0; q < 4; ++q)
#pragma unroll
                for (int j = 0; j < 4; ++j) v[q][j] = ((const f32x4*)(IN(0) + (size_t)(m + q * NGW) * DM))[lane + 64 * j];
#pragma unroll
            for (int q = 0; q < 4; ++q) { float sq = 0.f; unsigned long long* o8 = (unsigned long long*)(xb + (size_t)(m + q * NGW) * DM) + lane;
#pragma unroll
                for (int j = 0; j < 4; ++j) { const f32x4 w = v[q][j]; sq += (w[0] * w[0] + w[1] * w[1]) + (w[2] * w[2] + w[3] * w[3]);
                    o8[64 * j] = (unsigned long long)cvtpk(w[0], w[1]) | ((unsigned long long)cvtpk(w[2], w[3]) << 32); }
                sq = wave_sum(sq); if (lane < 16) SSQ(0)[(size_t)(m + q * NGW) * 16 + lane] = (lane == 0) ? sq : 0.f; }
        }
        for (int m = gw; m < MMEM; m += NGW) row_to_bf16(IN(1) + (size_t)m * DM, memb + (size_t)m * DM, SSQ(SSQ_MEM) + (size_t)m * 16, lane);
    }
    PHASE_END

#define RUN_GEMM(EPI_T, epi, Aptr, lda_, Bptr, ldb_, M_, N_, K_) do { pg8::Gemm g_{(const bf16_t*)(Aptr), (const bf16_t*)(Bptr), (M_), (N_), (K_), (lda_), (ldb_)}; \
        pg8::StaticOrder S_; S_.init((M_), (N_), G, bid); pg8::gemm_phase<EPI_T>(lds, g_, S_, epi, wave_s); } while (0)
#define SNAKE(r_) ((r_) * G + (((r_) & 1) ? (G - 1 - bid) : bid))

    int nssq = 0;
    const float* xcur = P.in[0];
    { constexpr int layer = 0, half = 0;
            if constexpr (half == 1) {
                if constexpr (layer == 0) {
                    PHASE_BEGIN
                    { pg8::EpiQK0 e{(bf16_t*)(ws + WS_QK0), SSQ(nssq), IN(9), IN(10), 0.125f * LOG2E};
                      RUN_GEMM(pg8::EpiQK0, e, xb, DM, ws + WS_WQK0, DM, MTOK, 2048, DM);
                      pg8::EpiOutT et{(bf16_t*)(ws + WS_VT0), MTOK, SSQ(nssq), 1.0f / DM};
                      RUN_GEMM(pg8::EpiOutT, et, ws + WS_WV0, DM, xb, DM, 1024, MTOK, DM); }
                    PHASE_END
                    PHASE_BEGIN
                    { const bf16_t* QK = (const bf16_t*)(ws + WS_QK0); const bf16_t* VT = (const bf16_t*)(ws + WS_VT0);
                      float la = IN(11)[lane] * IN(12)[lane], lb2 = IN(13)[lane] * IN(14)[lane];
                      la = wave_sum(la); lb2 = wave_sum(lb2);
                      const float lam = expf(la) - expf(lb2) + 0.2f;
                      for (int rep = 0; rep < REP_ATT; ++rep) for (int r = 0;; ++r) { const int u = SNAKE(r); if (u >= 512) break;
                          const int qb = 15 - (u >> 5), bh = u & 31, b = bh >> 2, h = bh & 3;
                          attn_unit<64, 128, 0, 0, true>(lds, QK + (size_t)b * SEQ * 2048 + h * 64, 2048, QK + (size_t)b * SEQ * 2048 + 512 + h * 64, 2048,
                                                VT + (size_t)(h * 128) * MTOK + (size_t)b * SEQ, MTOK, (bf16_t*)(ws + WS_MIX0) + (size_t)b * SEQ * 1024 + h * 128, 1024,
                                                qb * 256, qb * 4 + 4, 0.125f * LOG2E, nullptr, IN(15), lam, 0.8f, wave_s); }
                      for (int rep = 0; rep < REP_ATT; ++rep) for (int r = 0;; ++r) { const int u = SNAKE(r); if (u >= 1024) break;
                          const int qb = 15 - (u >> 6), bh = u & 63, b = bh >> 3, h = bh & 7;
                          attn_unit<64, 64, 1, 0, false>(lds, QK + (size_t)b * SEQ * 2048 + 1024 + h * 64, 2048, QK + (size_t)b * SEQ * 2048 + 1536 + h * 64, 2048,
                                               VT + (size_t)(512 + h * 64) * MTOK + (size_t)b * SEQ, MTOK, (bf16_t*)(ws + WS_MIX0) + (size_t)b * SEQ * 1024 + 512 + h * 64, 1024,
                                               qb * 256, qb * 4 + 4, 0.125f * LOG2E, nullptr, nullptr, 0.f, 0.f, wave_s); } }
                    PHASE_END
                    PHASE_BEGIN
                    { pg8::EpiResidB<1> e{nullptr, nullptr, xb, SSQ(nssq + 1), 1.0f};
                      RUN_GEMM(pg8::EpiResidB<1>, e, ws + WS_MIX0, DM, ws + WS_WOUT0, DM, MTOK, DM, DM); }
                    PHASE_END
                    ++nssq;
                } else {
                    PHASE_BEGIN
                    { pg8::EpiOut e{(bf16_t*)(ws + WS_T1), 1024, SSQ(nssq), 1.0f / DM, 0, 0, {SSQ(SSQ_MQ), SSQ(SSQ_MQ), SSQ(SSQ_MKV), nullptr}};
                      RUN_GEMM(pg8::EpiOut, e, xb, DM, ws + WS_WD1, DM, MTOK, 1024, DM); }
                    PHASE_END
                    PHASE_BEGIN
                    { const bf16_t* T1 = (const bf16_t*)(ws + WS_T1);
                      pg8::EpiOut eq{(bf16_t*)(ws + WS_Q1), 1536, SSQ(SSQ_MQ), 1.0f / 512.0f, 0, 0, {nullptr, nullptr, nullptr, nullptr}};
                      RUN_GEMM(pg8::EpiOut, eq, T1, 1024, ws + WS_WUQ, 512, MTOK, 1536, 512);
                      pg8::EpiK1 ek{(bf16_t*)(ws + WS_K1), T1, SSQ(SSQ_MKV), IN(23)};
                      RUN_GEMM(pg8::EpiK1, ek, T1 + 512, 1024, ws + WS_WUKVK, 256, MTOK, 1024, 256);
                      pg8::EpiOutT ev{(bf16_t*)(ws + WS_VT1), MTOK, SSQ(SSQ_MKV), 1.0f / 256.0f};
                      RUN_GEMM(pg8::EpiOutT, ev, ws + WS_WUKVV, 256, T1 + 512, 1024, 1024, MTOK, 256); }
                    PHASE_END
                    PHASE_BEGIN
                    { const bf16_t* Q1 = (const bf16_t*)(ws + WS_Q1); const bf16_t* K1 = (const bf16_t*)(ws + WS_K1); const bf16_t* VT = (const bf16_t*)(ws + WS_VT1);
                      for (int rep = 0; rep < REP_ATT; ++rep) for (int r = 0;; ++r) { const int u = SNAKE(r); if (u >= 2048) break;
                          const int qb = 15 - (u >> 7), bh = u & 127, b = bh >> 4, h = bh & 15;
                          attn_unit<96, 64, 0, 3, false>(lds, Q1 + (size_t)b * SEQ * 1536 + h * 96, 1536, K1 + (size_t)b * SEQ * 1536 + h * 96, 1536,
                                               VT + (size_t)(h * 64) * MTOK + (size_t)b * SEQ, MTOK, (bf16_t*)(ws + WS_O1) + (size_t)b * SEQ * 1024 + h * 64, 1024,
                                               qb * 256, qb * 4 + 4, 0.10206207261596575f * LOG2E, IN(22), nullptr, 0.f, 0.f, wave_s); } }
                    PHASE_END
                    PHASE_BEGIN
                    { pg8::EpiResidB<1> e{nullptr, nullptr, xb, SSQ(nssq + 1), 1.0f};
                      RUN_GEMM(pg8::EpiResidB<1>, e, ws + WS_O1, DM, ws + WS_WO1, DM, MTOK, DM, DM); }
                    PHASE_END
                    ++nssq;
                }
                {
#define xmw ((const bf16_t*)(ws + WS_XM + layer * 4 * MiB))
                    PHASE_BEGIN
                    { pg8::EpiOut e{(bf16_t*)(ws + WS_XQ), 512, SSQ(nssq), 1.0f / DM, 0, 0, {nullptr, nullptr, nullptr, nullptr}};
                      RUN_GEMM(pg8::EpiOut, e, xb, DM, xmw, DM, MTOK, 512, DM); }
                    PHASE_END
                    PHASE_BEGIN
                    { const bf16_t* XQ = (const bf16_t*)(ws + WS_XQ); const bf16_t* KM = (const bf16_t*)(ws + WS_KMEM) + (size_t)layer * MMEM * 512;
                      const bf16_t* VM = (const bf16_t*)(ws + WS_VTMEM) + (size_t)layer * 512 * MMEM;
                      for (int rep = 0; rep < REP_ATT; ++rep) for (int r = 0;; ++r) { const int u = r * G + bid; if (u >= 512) break;
                          const int qb = u >> 5, bh = u & 31, b = bh >> 2, h = bh & 3;
                          attn_unit<128, 128, 2, 1, false>(lds, XQ + (size_t)b * SEQ * 512 + h * 128, 512, KM + (size_t)b * MEMLEN * 512 + h * 128, 512,
                                                 VM + (size_t)(h * 128) * MMEM + (size_t)b * MEMLEN, MMEM, (bf16_t*)(ws + WS_XO) + (size_t)b * SEQ * 512 + h * 128, 512,
                                                 qb * 256, 4, 0.08838834764831845f * LOG2E, IN(29) + layer * 128, nullptr, 0.f, 0.f, wave_s); } }
                    PHASE_END
                    PHASE_BEGIN
                    { pg8::EpiResidB<1> e{nullptr, nullptr, xb, SSQ(nssq + 1), 1.0f};
                      RUN_GEMM(pg8::EpiResidB<1>, e, ws + WS_XO, 512, xmw + 3 * 512 * 1024, 512, MTOK, DM, 512); }
                    PHASE_END
                    ++nssq;
#undef xmw
                }
            }
            const int f = layer * 2 + half;
            PHASE_BEGIN
            { pg8::EpiSwiGLU e{(bf16_t*)(ws + WS_H), SSQ(nssq)};
              for (int rep = 0; rep < REP_G1; ++rep) RUN_GEMM(pg8::EpiSwiGLU, e, xb, DM, ws + WS_FFN + f * SZ_FFN, DM, MTOK, 2 * DFF, DM);
              if constexpr (layer == 0 && half == 0) {
                  for (int l = 0; l < 2; ++l) {
                      const bf16_t* xmw = (const bf16_t*)(ws + WS_XM + l * 4 * MiB);
                      pg8::EpiOut ek{(bf16_t*)(ws + WS_KMEM) + (size_t)l * MMEM * 512, 512, SSQ(SSQ_MEM), 1.0f / DM, 0, 0, {nullptr, nullptr, nullptr, nullptr}};
                      RUN_GEMM(pg8::EpiOut, ek, memb, DM, xmw + 512 * 1024, DM, MMEM, 512, DM);
                      pg8::EpiOutT ev{(bf16_t*)(ws + WS_VTMEM) + (size_t)l * 512 * MMEM, MMEM, SSQ(SSQ_MEM), 1.0f / DM};
                      RUN_GEMM(pg8::EpiOutT, ev, xmw + 2 * 512 * 1024, DM, memb, DM, 512, MMEM, DM);
                  }
              } }
            PHASE_END
            PHASE_BEGIN
            { constexpr int RMV = (layer == 0 && half == 0) ? 0 : ((layer == 1 && half == 1) ? 2 : 1);
              pg8::EpiResidB<RMV> e{IN(0), xout, xb, SSQ(nssq + 1), 0.5f};
              RUN_GEMM(pg8::EpiResidB<RMV>, e, ws + WS_H, DFF, ws + WS_FFN + f * SZ_FFN + SZ_WGU, DFF, MTOK, DM, DFF);
              if constexpr (layer == 0 && half == 0) {
                  for (int l = 0; l < 2; ++l) pp_norm128((bf16_t*)(ws + WS_KMEM) + (size_t)l * MMEM * 512, MMEM * 4, IN(30) + l * 128, gw, NGW, lane);
              } }
            PHASE_END
            ++nssq; xcur = xout;
    }
    { constexpr int layer = 0, half = 1;
            if constexpr (half == 1) {
                if constexpr (layer == 0) {
                    PHASE_BEGIN
                    { pg8::EpiQK0 e{(bf16_t*)(ws + WS_QK0), SSQ(nssq), IN(9), IN(10), 0.125f * LOG2E};
                      RUN_GEMM(pg8::EpiQK0, e, xb, DM, ws + WS_WQK0, DM, MTOK, 2048, DM);
                      pg8::EpiOutT et{(bf16_t*)(ws + WS_VT0), MTOK, SSQ(nssq), 1.0f / DM};
                      RUN_GEMM(pg8::EpiOutT, et, ws + WS_WV0, DM, xb, DM, 1024, MTOK, DM); }
                    PHASE_END
                    PHASE_BEGIN
                    { const bf16_t* QK = (const bf16_t*)(ws + WS_QK0); const bf16_t* VT = (const bf16_t*)(ws + WS_VT0);
                      float la = IN(11)[lane] * IN(12)[lane], lb2 = IN(13)[lane] * IN(14)[lane];
                      la = wave_sum(la); lb2 = wave_sum(lb2);
                      const float lam = expf(la) - expf(lb2) + 0.2f;
                      for (int rep = 0; rep < REP_ATT; ++rep) for (int r = 0;; ++r) { const int u = SNAKE(r); if (u >= 512) break;
                          const int qb = 15 - (u >> 5), bh = u & 31, b = bh >> 2, h = bh & 3;
                          attn_unit<64, 128, 0, 0, true>(lds, QK + (size_t)b * SEQ * 2048 + h * 64, 2048, QK + (size_t)b * SEQ * 2048 + 512 + h * 64, 2048,
                                                VT + (size_t)(h * 128) * MTOK + (size_t)b * SEQ, MTOK, (bf16_t*)(ws + WS_MIX0) + (size_t)b * SEQ * 1024 + h * 128, 1024,
                                                qb * 256, qb * 4 + 4, 0.125f * LOG2E, nullptr, IN(15), lam, 0.8f, wave_s); }
                      for (int rep = 0; rep < REP_ATT; ++rep) for (int r = 0;; ++r) { const int u = SNAKE(r); if (u >= 1024) break;
                          const int qb = 15 - (u >> 6), bh = u & 63, b = bh >> 3, h = bh & 7;
                          attn_unit<64, 64, 1, 0, false>(lds, QK + (size_t)b * SEQ * 2048 + 1024 + h * 64, 2048, QK + (size_t)b * SEQ * 2048 + 1536 + h * 64, 2048,
                                               VT + (size_t)(512 + h * 64) * MTOK + (size_t)b * SEQ, MTOK, (bf16_t*)(ws + WS_MIX0) + (size_t)b * SEQ * 1024 + 512 + h * 64, 1024,
                                               qb * 256, qb * 4 + 4, 0.125f * LOG2E, nullptr, nullptr, 0.f, 0.f, wave_s); } }
                    PHASE_END
                    PHASE_BEGIN
                    { pg8::EpiResidB<1> e{nullptr, nullptr, xb, SSQ(nssq + 1), 1.0f};
                      RUN_GEMM(pg8::EpiResidB<1>, e, ws + WS_MIX0, DM, ws + WS_WOUT0, DM, MTOK, DM, DM); }
                    PHASE_END
                    ++nssq;
                } else {
                    PHASE_BEGIN
                    { pg8::EpiOut e{(bf16_t*)(ws + WS_T1), 1024, SSQ(nssq), 1.0f / DM, 0, 0, {SSQ(SSQ_MQ), SSQ(SSQ_MQ), SSQ(SSQ_MKV), nullptr}};
                      RUN_GEMM(pg8::EpiOut, e, xb, DM, ws + WS_WD1, DM, MTOK, 1024, DM); }
                    PHASE_END
                    PHASE_BEGIN
                    { const bf16_t* T1 = (const bf16_t*)(ws + WS_T1);
                      pg8::EpiOut eq{(bf16_t*)(ws + WS_Q1), 1536, SSQ(SSQ_MQ), 1.0f / 512.0f, 0, 0, {nullptr, nullptr, nullptr, nullptr}};
                      RUN_GEMM(pg8::EpiOut, eq, T1, 1024, ws + WS_WUQ, 512, MTOK, 1536, 512);
                      pg8::EpiK1 ek{(bf16_t*)(ws + WS_K1), T1, SSQ(SSQ_MKV), IN(23)};
                      RUN_GEMM(pg8::EpiK1, ek, T1 + 512, 1024, ws + WS_WUKVK, 256, MTOK, 1024, 256);
                      pg8::EpiOutT ev{(bf16_t*)(ws + WS_VT1), MTOK, SSQ(SSQ_MKV), 1.0f / 256.0f};
                      RUN_GEMM(pg8::EpiOutT, ev, ws + WS_WUKVV, 256, T1 + 512, 1024, 1024, MTOK, 256); }
                    PHASE_END
                    PHASE_BEGIN
                    { const bf16_t* Q1 = (const bf16_t*)(ws + WS_Q1); const bf16_t* K1 = (const bf16_t*)(ws + WS_K1); const bf16_t* VT = (const bf16_t*)(ws + WS_VT1);
                      for (int rep = 0; rep < REP_ATT; ++rep) for (int r = 0;; ++r) { const int u = SNAKE(r); if (u >= 2048) break;
                          const int qb = 15 - (u >> 7), bh = u & 127, b = bh >> 4, h = bh & 15;
                          attn_unit<96, 64, 0, 3, false>(lds, Q1 + (size_t)b * SEQ * 1536 + h * 96, 1536, K1 + (size_t)b * SEQ * 1536 + h * 96, 1536,
                                               VT + (size_t)(h * 64) * MTOK + (size_t)b * SEQ, MTOK, (bf16_t*)(ws + WS_O1) + (size_t)b * SEQ * 1024 + h * 64, 1024,
                                               qb * 256, qb * 4 + 4, 0.10206207261596575f * LOG2E, IN(22), nullptr, 0.f, 0.f, wave_s); } }
                    PHASE_END
                    PHASE_BEGIN
                    { pg8::EpiResidB<1> e{nullptr, nullptr, xb, SSQ(nssq + 1), 1.0f};
                      RUN_GEMM(pg8::EpiResidB<1>, e, ws + WS_O1, DM, ws + WS_WO1, DM, MTOK, DM, DM); }
                    PHASE_END
                    ++nssq;
                }
                {
#define xmw ((const bf16_t*)(ws + WS_XM + layer * 4 * MiB))
                    PHASE_BEGIN
                    { pg8::EpiOut e{(bf16_t*)(ws + WS_XQ), 512, SSQ(nssq), 1.0f / DM, 0, 0, {nullptr, nullptr, nullptr, nullptr}};
                      RUN_GEMM(pg8::EpiOut, e, xb, DM, xmw, DM, MTOK, 512, DM); }
                    PHASE_END
                    PHASE_BEGIN
                    { const bf16_t* XQ = (const bf16_t*)(ws + WS_XQ); const bf16_t* KM = (const bf16_t*)(ws + WS_KMEM) + (size_t)layer * MMEM * 512;
                      const bf16_t* VM = (const bf16_t*)(ws + WS_VTMEM) + (size_t)layer * 512 * MMEM;
                      for (int rep = 0; rep < REP_ATT; ++rep) for (int r = 0;; ++r) { const int u = r * G + bid; if (u >= 512) break;
                          const int qb = u >> 5, bh = u & 31, b = bh >> 2, h = bh & 3;
                          attn_unit<128, 128, 2, 1, false>(lds, XQ + (size_t)b * SEQ * 512 + h * 128, 512, KM + (size_t)b * MEMLEN * 512 + h * 128, 512,
                                                 VM + (size_t)(h * 128) * MMEM + (size_t)b * MEMLEN, MMEM, (bf16_t*)(ws + WS_XO) + (size_t)b * SEQ * 512 + h * 128, 512,
                                                 qb * 256, 4, 0.08838834764831845f * LOG2E, IN(29) + layer * 128, nullptr, 0.f, 0.f, wave_s); } }
                    PHASE_END
                    PHASE_BEGIN
                    { pg8::EpiResidB<1> e{nullptr, nullptr, xb, SSQ(nssq + 1), 1.0f};
                      RUN_GEMM(pg8::EpiResidB<1>, e, ws + WS_XO, 512, xmw + 3 * 512 * 1024, 512, MTOK, DM, 512); }
                    PHASE_END
                    ++nssq;
#undef xmw
                }
            }
            const int f = layer * 2 + half;
            PHASE_BEGIN
            { pg8::EpiSwiGLU e{(bf16_t*)(ws + WS_H), SSQ(nssq)};
              for (int rep = 0; rep < REP_G1; ++rep) RUN_GEMM(pg8::EpiSwiGLU, e, xb, DM, ws + WS_FFN + f * SZ_FFN, DM, MTOK, 2 * DFF, DM);
              if constexpr (layer == 0 && half == 0) {
                  for (int l = 0; l < 2; ++l) {
                      const bf16_t* xmw = (const bf16_t*)(ws + WS_XM + l * 4 * MiB);
                      pg8::EpiOut ek{(bf16_t*)(ws + WS_KMEM) + (size_t)l * MMEM * 512, 512, SSQ(SSQ_MEM), 1.0f / DM, 0, 0, {nullptr, nullptr, nullptr, nullptr}};
                      RUN_GEMM(pg8::EpiOut, ek, memb, DM, xmw + 512 * 1024, DM, MMEM, 512, DM);
                      pg8::EpiOutT ev{(bf16_t*)(ws + WS_VTMEM) + (size_t)l * 512 * MMEM, MMEM, SSQ(SSQ_MEM), 1.0f / DM};
                      RUN_GEMM(pg8::EpiOutT, ev, xmw + 2 * 512 * 1024, DM, memb, DM, 512, MMEM, DM);
                  }
              } }
            PHASE_END
            PHASE_BEGIN
            { constexpr int RMV = (layer == 0 && half == 0) ? 0 : ((layer == 1 && half == 1) ? 2 : 1);
              pg8::EpiResidB<RMV> e{IN(0), xout, xb, SSQ(nssq + 1), 0.5f};
              RUN_GEMM(pg8::EpiResidB<RMV>, e, ws + WS_H, DFF, ws + WS_FFN + f * SZ_FFN + SZ_WGU, DFF, MTOK, DM, DFF);
              if constexpr (layer == 0 && half == 0) {
                  for (int l = 0; l < 2; ++l) pp_norm128((bf16_t*)(ws + WS_KMEM) + (size_t)l * MMEM * 512, MMEM * 4, IN(30) + l * 128, gw, NGW, lane);
              } }
            PHASE_END
            ++nssq; xcur = xout;
    }
    { constexpr int layer = 1, half = 0;
            if constexpr (half == 1) {
                if constexpr (layer == 0) {
                    PHASE_BEGIN
                    { pg8::EpiQK0 e{(bf16_t*)(ws + WS_QK0), SSQ(nssq), IN(9), IN(10), 0.125f * LOG2E};
                      RUN_GEMM(pg8::EpiQK0, e, xb, DM, ws + WS_WQK0, DM, MTOK, 2048, DM);
                      pg8::EpiOutT et{(bf16_t*)(ws + WS_VT0), MTOK, SSQ(nssq), 1.0f / DM};
                      RUN_GEMM(pg8::EpiOutT, et, ws + WS_WV0, DM, xb, DM, 1024, MTOK, DM); }
                    PHASE_END
                    PHASE_BEGIN
                    { const bf16_t* QK = (const bf16_t*)(ws + WS_QK0); const bf16_t* VT = (const bf16_t*)(ws + WS_VT0);
                      float la = IN(11)[lane] * IN(12)[lane], lb2 = IN(13)[lane] * IN(14)[lane];
                      la = wave_sum(la); lb2 = wave_sum(lb2);
                      const float lam = expf(la) - expf(lb2) + 0.2f;
                      for (int rep = 0; rep < REP_ATT; ++rep) for (int r = 0;; ++r) { const int u = SNAKE(r); if (u >= 512) break;
                          const int qb = 15 - (u >> 5), bh = u & 31, b = bh >> 2, h = bh & 3;
                          attn_unit<64, 128, 0, 0, true>(lds, QK + (size_t)b * SEQ * 2048 + h * 64, 2048, QK + (size_t)b * SEQ * 2048 + 512 + h * 64, 2048,
                                                VT + (size_t)(h * 128) * MTOK + (size_t)b * SEQ, MTOK, (bf16_t*)(ws + WS_MIX0) + (size_t)b * SEQ * 1024 + h * 128, 1024,
                                                qb * 256, qb * 4 + 4, 0.125f * LOG2E, nullptr, IN(15), lam, 0.8f, wave_s); }
                      for (int rep = 0; rep < REP_ATT; ++rep) for (int r = 0;; ++r) { const int u = SNAKE(r); if (u >= 1024) break;
                          const int qb = 15 - (u >> 6), bh = u & 63, b = bh >> 3, h = bh & 7;
                          attn_unit<64, 64, 1, 0, false>(lds, QK + (size_t)b * SEQ * 2048 + 1024 + h * 64, 2048, QK + (size_t)b * SEQ * 2048 + 1536 + h * 64, 2048,
                                               VT + (size_t)(512 + h * 64) * MTOK + (size_t)b * SEQ, MTOK, (bf16_t*)(ws + WS_MIX0) + (size_t)b * SEQ * 1024 + 512 + h * 64, 1024,
                                               qb * 256, qb * 4 + 4, 0.125f * LOG2E, nullptr, nullptr, 0.f, 0.f, wave_s); } }
                    PHASE_END
                    PHASE_BEGIN
                    { pg8::EpiResidB<1> e{nullptr, nullptr, xb, SSQ(nssq + 1), 1.0f};
                      RUN_GEMM(pg8::EpiResidB<1>, e, ws + WS_MIX0, DM, ws + WS_WOUT0, DM, MTOK, DM, DM); }
                    PHASE_END
                    ++nssq;
                } else {
                    PHASE_BEGIN
                    { pg8::EpiOut e{(bf16_t*)(ws + WS_T1), 1024, SSQ(nssq), 1.0f / DM, 0, 0, {SSQ(SSQ_MQ), SSQ(SSQ_MQ), SSQ(SSQ_MKV), nullptr}};
                      RUN_GEMM(pg8::EpiOut, e, xb, DM, ws + WS_WD1, DM, MTOK, 1024, DM); }
                    PHASE_END
                    PHASE_BEGIN
                    { const bf16_t* T1 = (const bf16_t*)(ws + WS_T1);
                      pg8::EpiOut eq{(bf16_t*)(ws + WS_Q1), 1536, SSQ(SSQ_MQ), 1.0f / 512.0f, 0, 0, {nullptr, nullptr, nullptr, nullptr}};
                      RUN_GEMM(pg8::EpiOut, eq, T1, 1024, ws + WS_WUQ, 512, MTOK, 1536, 512);
                      pg8::EpiK1 ek{(bf16_t*)(ws + WS_K1), T1, SSQ(SSQ_MKV), IN(23)};
                      RUN_GEMM(pg8::EpiK1, ek, T1 + 512, 1024, ws + WS_WUKVK, 256, MTOK, 1024, 256);
                      pg8::EpiOutT ev{(bf16_t*)(ws + WS_VT1), MTOK, SSQ(SSQ_MKV), 1.0f / 256.0f};
                      RUN_GEMM(pg8::EpiOutT, ev, ws + WS_WUKVV, 256, T1 + 512, 1024, 1024, MTOK, 256); }
                    PHASE_END
                    PHASE_BEGIN
                    { const bf16_t* Q1 = (const bf16_t*)(ws + WS_Q1); const bf16_t* K1 = (const bf16_t*)(ws + WS_K1); const bf16_t* VT = (const bf16_t*)(ws + WS_VT1);
                      for (int rep = 0; rep < REP_ATT; ++rep) for (int r = 0;; ++r) { const int u = SNAKE(r); if (u >= 2048) break;
                          const int qb = 15 - (u >> 7), bh = u & 127, b = bh >> 4, h = bh & 15;
                          attn_unit<96, 64, 0, 3, false>(lds, Q1 + (size_t)b * SEQ * 1536 + h * 96, 1536, K1 + (size_t)b * SEQ * 1536 + h * 96, 1536,
                                               VT + (size_t)(h * 64) * MTOK + (size_t)b * SEQ, MTOK, (bf16_t*)(ws + WS_O1) + (size_t)b * SEQ * 1024 + h * 64, 1024,
                                               qb * 256, qb * 4 + 4, 0.10206207261596575f * LOG2E, IN(22), nullptr, 0.f, 0.f, wave_s); } }
                    PHASE_END
                    PHASE_BEGIN
                    { pg8::EpiResidB<1> e{nullptr, nullptr, xb, SSQ(nssq + 1), 1.0f};
                      RUN_GEMM(pg8::EpiResidB<1>, e, ws + WS_O1, DM, ws + WS_WO1, DM, MTOK, DM, DM); }
                    PHASE_END
                    ++nssq;
                }
                {
#define xmw ((const bf16_t*)(ws + WS_XM + layer * 4 * MiB))
                    PHASE_BEGIN
                    { pg8::EpiOut e{(bf16_t*)(ws + WS_XQ), 512, SSQ(nssq), 1.0f / DM, 0, 0, {nullptr, nullptr, nullptr, nullptr}};
                      RUN_GEMM(pg8::EpiOut, e, xb, DM, xmw, DM, MTOK, 512, DM); }
                    PHASE_END
                    PHASE_BEGIN
                    { const bf16_t* XQ = (const bf16_t*)(ws + WS_XQ); const bf16_t* KM = (const bf16_t*)(ws + WS_KMEM) + (size_t)layer * MMEM * 512;
                      const bf16_t* VM = (const bf16_t*)(ws + WS_VTMEM) + (size_t)layer * 512 * MMEM;
                      for (int rep = 0; rep < REP_ATT; ++rep) for (int r = 0;; ++r) { const int u = r * G + bid; if (u >= 512) break;
                          const int qb = u >> 5, bh = u & 31, b = bh >> 2, h = bh & 3;
                          attn_unit<128, 128, 2, 1, false>(lds, XQ + (size_t)b * SEQ * 512 + h * 128, 512, KM + (size_t)b * MEMLEN * 512 + h * 128, 512,
                                                 VM + (size_t)(h * 128) * MMEM + (size_t)b * MEMLEN, MMEM, (bf16_t*)(ws + WS_XO) + (size_t)b * SEQ * 512 + h * 128, 512,
                                                 qb * 256, 4, 0.08838834764831845f * LOG2E, IN(29) + layer * 128, nullptr, 0.f, 0.f, wave_s); } }
                    PHASE_END
                    PHASE_BEGIN
                    { pg8::EpiResidB<1> e{nullptr, nullptr, xb, SSQ(nssq + 1), 1.0f};
                      RUN_GEMM(pg8::EpiResidB<1>, e, ws + WS_XO, 512, xmw + 3 * 512 * 1024, 512, MTOK, DM, 512); }
                    PHASE_END
                    ++nssq;
#undef xmw
                }
            }
            const int f = layer * 2 + half;
            PHASE_BEGIN
            { pg8::EpiSwiGLU e{(bf16_t*)(ws + WS_H), SSQ(nssq)};
              for (int rep = 0; rep < REP_G1; ++rep) RUN_GEMM(pg8::EpiSwiGLU, e, xb, DM, ws + WS_FFN + f * SZ_FFN, DM, MTOK, 2 * DFF, DM);
              if constexpr (layer == 0 && half == 0) {
                  for (int l = 0; l < 2; ++l) {
                      const bf16_t* xmw = (const bf16_t*)(ws + WS_XM + l * 4 * MiB);
                      pg8::EpiOut ek{(bf16_t*)(ws + WS_KMEM) + (size_t)l * MMEM * 512, 512, SSQ(SSQ_MEM), 1.0f / DM, 0, 0, {nullptr, nullptr, nullptr, nullptr}};
                      RUN_GEMM(pg8::EpiOut, ek, memb, DM, xmw + 512 * 1024, DM, MMEM, 512, DM);
                      pg8::EpiOutT ev{(bf16_t*)(ws + WS_VTMEM) + (size_t)l * 512 * MMEM, MMEM, SSQ(SSQ_MEM), 1.0f / DM};
                      RUN_GEMM(pg8::EpiOutT, ev, xmw + 2 * 512 * 1024, DM, memb, DM, 512, MMEM, DM);
                  }
              } }
            PHASE_END
            PHASE_BEGIN
            { constexpr int RMV = (layer == 0 && half == 0) ? 0 : ((layer == 1 && half == 1) ? 2 : 1);
              pg8::EpiResidB<RMV> e{IN(0), xout, xb, SSQ(nssq + 1), 0.5f};
              RUN_GEMM(pg8::EpiResidB<RMV>, e, ws + WS_H, DFF, ws + WS_FFN + f * SZ_FFN + SZ_WGU, DFF, MTOK, DM, DFF);
              if constexpr (layer == 0 && half == 0) {
                  for (int l = 0; l < 2; ++l) pp_norm128((bf16_t*)(ws + WS_KMEM) + (size_t)l * MMEM * 512, MMEM * 4, IN(30) + l * 128, gw, NGW, lane);
              } }
            PHASE_END
            ++nssq; xcur = xout;
    }
    { constexpr int layer = 1, half = 1;
            if constexpr (half == 1) {
                if constexpr (layer == 0) {
                    PHASE_BEGIN
                    { pg8::EpiQK0 e{(bf16_t*)(ws + WS_QK0), SSQ(nssq), IN(9), IN(10), 0.125f * LOG2E};
                      RUN_GEMM(pg8::EpiQK0, e, xb, DM, ws + WS_WQK0, DM, MTOK, 2048, DM);
                      pg8::EpiOutT et{(bf16_t*)(ws + WS_VT0), MTOK, SSQ(nssq), 1.0f / DM};
                      RUN_GEMM(pg8::EpiOutT, et, ws + WS_WV0, DM, xb, DM, 1024, MTOK, DM); }
                    PHASE_END
                    PHASE_BEGIN
                    { const bf16_t* QK = (const bf16_t*)(ws + WS_QK0); const bf16_t* VT = (const bf16_t*)(ws + WS_VT0);
                      float la = IN(11)[lane] * IN(12)[lane], lb2 = IN(13)[lane] * IN(14)[lane];
                      la = wave_sum(la); lb2 = wave_sum(lb2);
                      const float lam = expf(la) - expf(lb2) + 0.2f;
                      for (int rep = 0; rep < REP_ATT; ++rep) for (int r = 0;; ++r) { const int u = SNAKE(r); if (u >= 512) break;
                          const int qb = 15 - (u >> 5), bh = u & 31, b = bh >> 2, h = bh & 3;
                          attn_unit<64, 128, 0, 0, true>(lds, QK + (size_t)b * SEQ * 2048 + h * 64, 2048, QK + (size_t)b * SEQ * 2048 + 512 + h * 64, 2048,
                                                VT + (size_t)(h * 128) * MTOK + (size_t)b * SEQ, MTOK, (bf16_t*)(ws + WS_MIX0) + (size_t)b * SEQ * 1024 + h * 128, 1024,
                                                qb * 256, qb * 4 + 4, 0.125f * LOG2E, nullptr, IN(15), lam, 0.8f, wave_s); }
                      for (int rep = 0; rep < REP_ATT; ++rep) for (int r = 0;; ++r) { const int u = SNAKE(r); if (u >= 1024) break;
                          const int qb = 15 - (u >> 6), bh = u & 63, b = bh >> 3, h = bh & 7;
                          attn_unit<64, 64, 1, 0, false>(lds, QK + (size_t)b * SEQ * 2048 + 1024 + h * 64, 2048, QK + (size_t)b * SEQ * 2048 + 1536 + h * 64, 2048,
                                               VT + (size_t)(512 + h * 64) * MTOK + (size_t)b * SEQ, MTOK, (bf16_t*)(ws + WS_MIX0) + (size_t)b * SEQ * 1024 + 512 + h * 64, 1024,
                                               qb * 256, qb * 4 + 4, 0.125f * LOG2E, nullptr, nullptr, 0.f, 0.f, wave_s); } }
                    PHASE_END
                    PHASE_BEGIN
                    { pg8::EpiResidB<1> e{nullptr, nullptr, xb, SSQ(nssq + 1), 1.0f};
                      RUN_GEMM(pg8::EpiResidB<1>, e, ws + WS_MIX0, DM, ws + WS_WOUT0, DM, MTOK, DM, DM); }
                    PHASE_END
                    ++nssq;
                } else {
                    PHASE_BEGIN
                    { pg8::EpiOut e{(bf16_t*)(ws + WS_T1), 1024, SSQ(nssq), 1.0f / DM, 0, 0, {SSQ(SSQ_MQ), SSQ(SSQ_MQ), SSQ(SSQ_MKV), nullptr}};
                      RUN_GEMM(pg8::EpiOut, e, xb, DM, ws + WS_WD1, DM, MTOK, 1024, DM); }
                    PHASE_END
                    PHASE_BEGIN
                    { const bf16_t* T1 = (const bf16_t*)(ws + WS_T1);
                      pg8::EpiOut eq{(bf16_t*)(ws + WS_Q1), 1536, SSQ(SSQ_MQ), 1.0f / 512.0f, 0, 0, {nullptr, nullptr, nullptr, nullptr}};
                      RUN_GEMM(pg8::EpiOut, eq, T1, 1024, ws + WS_WUQ, 512, MTOK, 1536, 512);
                      pg8::EpiK1 ek{(bf16_t*)(ws + WS_K1), T1, SSQ(SSQ_MKV), IN(23)};
                      RUN_GEMM(pg8::EpiK1, ek, T1 + 512, 1024, ws + WS_WUKVK, 256, MTOK, 1024, 256);
                      pg8::EpiOutT ev{(bf16_t*)(ws + WS_VT1), MTOK, SSQ(SSQ_MKV), 1.0f / 256.0f};
                      RUN_GEMM(pg8::EpiOutT, ev, ws + WS_WUKVV, 256, T1 + 512, 1024, 1024, MTOK, 256); }
                    PHASE_END
                    PHASE_BEGIN
                    { const bf16_t* Q1 = (const bf16_t*)(ws + WS_Q1); const bf16_t* K1 = (const bf16_t*)(ws + WS_K1); const bf16_t* VT = (const bf16_t*)(ws + WS_VT1);
                      for (int rep = 0; rep < REP_ATT; ++rep) for (int r = 0;; ++r) { const int u = SNAKE(r); if (u >= 2048) break;
                          const int qb = 15 - (u >> 7), bh = u & 127, b = bh >> 4, h = bh & 15;
                          attn_unit<96, 64, 0, 3, false>(lds, Q1 + (size_t)b * SEQ * 1536 + h * 96, 1536, K1 + (size_t)b * SEQ * 1536 + h * 96, 1536,
                                               VT + (size_t)(h * 64) * MTOK + (size_t)b * SEQ, MTOK, (bf16_t*)(ws + WS_O1) + (size_t)b * SEQ * 1024 + h * 64, 1024,
                                               qb * 256, qb * 4 + 4, 0.10206207261596575f * LOG2E, IN(22), nullptr, 0.f, 0.f, wave_s); } }
                    PHASE_END
                    PHASE_BEGIN
                    { pg8::EpiResidB<1> e{nullptr, nullptr, xb, SSQ(nssq + 1), 1.0f};
                      RUN_GEMM(pg8::EpiResidB<1>, e, ws + WS_O1, DM, ws + WS_WO1, DM, MTOK, DM, DM); }
                    PHASE_END
                    ++nssq;
                }
                {
#define xmw ((const bf16_t*)(ws + WS_XM + layer * 4 * MiB))
                    PHASE_BEGIN
                    { pg8::EpiOut e{(bf16_t*)(ws + WS_XQ), 512, SSQ(nssq), 1.0f / DM, 0, 0, {nullptr, nullptr, nullptr, nullptr}};
                      RUN_GEMM(pg8::EpiOut, e, xb, DM, xmw, DM, MTOK, 512, DM); }
                    PHASE_END
                    PHASE_BEGIN
                    { const bf16_t* XQ = (const bf16_t*)(ws + WS_XQ); const bf16_t* KM = (const bf16_t*)(ws + WS_KMEM) + (size_t)layer * MMEM * 512;
                      const bf16_t* VM = (const bf16_t*)(ws + WS_VTMEM) + (size_t)layer * 512 * MMEM;
                      for (int rep = 0; rep < REP_ATT; ++rep) for (int r = 0;; ++r) { const int u = r * G + bid; if (u >= 512) break;
                          const int qb = u >> 5, bh = u & 31, b = bh >> 2, h = bh & 3;
                          attn_unit<128, 128, 2, 1, false>(lds, XQ + (size_t)b * SEQ * 512 + h * 128, 512, KM + (size_t)b * MEMLEN * 512 + h * 128, 512,
                                                 VM + (size_t)(h * 128) * MMEM + (size_t)b * MEMLEN, MMEM, (bf16_t*)(ws + WS_XO) + (size_t)b * SEQ * 512 + h * 128, 512,
                                                 qb * 256, 4, 0.08838834764831845f * LOG2E, IN(29) + layer * 128, nullptr, 0.f, 0.f, wave_s); } }
                    PHASE_END
                    PHASE_BEGIN
                    { pg8::EpiResidB<1> e{nullptr, nullptr, xb, SSQ(nssq + 1), 1.0f};
                      RUN_GEMM(pg8::EpiResidB<1>, e, ws + WS_XO, 512, xmw + 3 * 512 * 1024, 512, MTOK, DM, 512); }
                    PHASE_END
                    ++nssq;
#undef xmw
                }
            }
            const int f = layer * 2 + half;
            PHASE_BEGIN
            { pg8::EpiSwiGLU e{(bf16_t*)(ws + WS_H), SSQ(nssq)};
              for (int rep = 0; rep < REP_G1; ++rep) RUN_GEMM(pg8::EpiSwiGLU, e, xb, DM, ws + WS_FFN + f * SZ_FFN, DM, MTOK, 2 * DFF, DM);
              if constexpr (layer == 0 && half == 0) {
                  for (int l = 0; l < 2; ++l) {
                      const bf16_t* xmw = (const bf16_t*)(ws + WS_XM + l * 4 * MiB);
                      pg8::EpiOut ek{(bf16_t*)(ws + WS_KMEM) + (size_t)l * MMEM * 512, 512, SSQ(SSQ_MEM), 1.0f / DM, 0, 0, {nullptr, nullptr, nullptr, nullptr}};
                      RUN_GEMM(pg8::EpiOut, ek, memb, DM, xmw + 512 * 1024, DM, MMEM, 512, DM);
                      pg8::EpiOutT ev{(bf16_t*)(ws + WS_VTMEM) + (size_t)l * 512 * MMEM, MMEM, SSQ(SSQ_MEM), 1.0f / DM};
                      RUN_GEMM(pg8::EpiOutT, ev, xmw + 2 * 512 * 1024, DM, memb, DM, 512, MMEM, DM);
                  }
              } }
            PHASE_END
            PHASE_BEGIN
            { constexpr int RMV = (layer == 0 && half == 0) ? 0 : ((layer == 1 && half == 1) ? 2 : 1);
              pg8::EpiResidB<RMV> e{IN(0), xout, xb, SSQ(nssq + 1), 0.5f};
              RUN_GEMM(pg8::EpiResidB<RMV>, e, ws + WS_H, DFF, ws + WS_FFN + f * SZ_FFN + SZ_WGU, DFF, MTOK, DM, DFF);
              if constexpr (layer == 0 && half == 0) {
                  for (int l = 0; l < 2; ++l) pp_norm128((bf16_t*)(ws + WS_KMEM) + (size_t)l * MMEM * 512, MMEM * 4, IN(30) + l * 128, gw, NGW, lane);
              } }
            PHASE_END
            ++nssq; xcur = xout;
    }
}

constexpr int N_PHASES = 22;
extern "C" void kernel_launch(void* const* d_in, const int* in_sizes, int n_in, void* d_out, int out_size, void* d_ws, size_t ws_size, hipStream_t stream) {
    static int grid = 0;
    if (grid == 0) {
        if (n_in != 32 || ws_size < WS_END) { fprintf(stderr, "kernel_launch: unexpected n_in %d / ws %zu\n", n_in, ws_size); grid = -1; return; }
        int dev = 0, cus = 0, per_cu = 0;
        hipGetDevice(&dev);
        hipDeviceGetAttribute(&cus, hipDeviceAttributeMultiprocessorCount, dev);
        hipFuncSetAttribute((const void*)fwd_kernel, hipFuncAttributeMaxDynamicSharedMemorySize, LDS_BYTES);
        hipOccupancyMaxActiveBlocksPerMultiprocessor(&per_cu, (const void*)fwd_kernel, 512, LDS_BYTES);
        if (per_cu < 1) per_cu = 1;
        grid = cus * per_cu;
        fprintf(stderr, "kernel_launch: cus %d per_cu %d grid %d\n", cus, per_cu, grid);
    }
    if (grid < 0) return;
    Params p{};
    for (int i = 0; i < 32; ++i) p.in[i] = (const float*)d_in[i];
    p.out = (float*)d_out; p.ws = (unsigned char*)d_ws;
    (void)hipMemsetAsync((char*)d_ws + WS_BAR, 0, BAR_BYTES, stream);
#ifdef MULTI_LAUNCH
    for (int k = 0; k < N_PHASES; ++k) { p.lo = k; p.hi = k + 1; hipLaunchKernelGGL(fwd_kernel, dim3(grid), dim3(512), LDS_BYTES, stream, p); }
#else
    p.lo = 0; p.hi = N_PHASES;
    void* args[] = {&p};
    hipError_t e = hipLaunchCooperativeKernel((const void*)fwd_kernel, dim3(grid), dim3(512), args, LDS_BYTES, stream);
    if (e != hipSuccess) fprintf(stderr, "cooperative launch failed: %s (grid %d)\n", hipGetErrorString(e), grid);
#endif
}
```

```cpp
#include <hip/hip_runtime.h>
#include <hip/hip_cooperative_groups.h>
#include <cstdio>
#include <cstdint>
namespace cg = cooperative_groups;

#define LAS __attribute__((address_space(3)))
typedef unsigned short bf16_t;
typedef short bf16x8 __attribute__((ext_vector_type(8)));
typedef short s16x4 __attribute__((ext_vector_type(4)));
typedef float f32x4 __attribute__((ext_vector_type(4)));
typedef float f32x16 __attribute__((ext_vector_type(16)));
typedef unsigned u32x4 __attribute__((ext_vector_type(4)));
typedef unsigned u32x2 __attribute__((ext_vector_type(2)));
typedef float f32x2_t __attribute__((ext_vector_type(2)));
typedef __bf16 bf16x2_t __attribute__((ext_vector_type(2)));


__device__ __forceinline__ int lane_now() { int l; asm volatile("v_mbcnt_lo_u32_b32 %0, -1, 0\n\tv_mbcnt_hi_u32_b32 %0, -1, %0" : "=v"(l)); return l; }

__device__ __forceinline__ float ssq_sum(const float* p) {
    const f32x4 a = *(const f32x4*)p, b = *(const f32x4*)(p + 4), c = *(const f32x4*)(p + 8), d = *(const f32x4*)(p + 12);
    return (((a[0] + a[1]) + (a[2] + a[3])) + ((b[0] + b[1]) + (b[2] + b[3]))) + (((c[0] + c[1]) + (c[2] + c[3])) + ((d[0] + d[1]) + (d[2] + d[3])));
}

__device__ __forceinline__ float fadd_s(float a, float b) { float r = a + b; asm("" : "+v"(r)); return r; }
__device__ __forceinline__ float fmul_s(float a, float b) { float r = a * b; asm("" : "+v"(r)); return r; }
constexpr int DM = 1024, NB = 8, SEQ = 4096, MTOK = NB * SEQ, DFF = 2816, MEMLEN = 256, MMEM = NB * MEMLEN;
constexpr float EPS = 1e-6f;
constexpr float LOG2E = 1.4426950408889634f;

__device__ __forceinline__ unsigned cvtpk(float lo, float hi) { f32x2_t v = {lo, hi}; bf16x2_t b = __builtin_convertvector(v, bf16x2_t); return __builtin_bit_cast(unsigned, b); }
__device__ __forceinline__ float bf2f(unsigned short h) { return __uint_as_float(((unsigned)h) << 16); }
__device__ __forceinline__ float bflo(unsigned w) { return __uint_as_float(w << 16); }
__device__ __forceinline__ float bfhi(unsigned w) { return __uint_as_float(w & 0xffff0000u); }

__device__ const double ROPE_REV[32] = {0.15915494309189535, 0.11934937021124886, 0.08949940160889101, 0.06711508300522726, 0.050329212104487035, 0.03774158471741977, 0.0283021958306234, 0.02122365276477766, 0.015915494309189534, 0.011934937021124886, 0.008949940160889102, 0.006711508300522725, 0.005032921210448704, 0.003774158471741977, 0.00283021958306234, 0.0021223652764777662, 0.0015915494309189536, 0.0011934937021124885, 0.0008949940160889102, 0.0006711508300522726, 0.0005032921210448703, 0.00037741584717419774, 0.00028302195830623395, 0.0002122365276477766, 0.00015915494309189535, 0.00011934937021124886, 8.949940160889102e-05, 6.711508300522725e-05, 5.0329212104487035e-05, 3.774158471741978e-05, 2.8302195830623396e-05, 2.122365276477766e-05};
__device__ __forceinline__ void rope_cs(int pos, int idx64, float& cs, float& sn) {
    const double rev = (double)pos * ROPE_REV[idx64];
    const float fr = (float)(rev - __builtin_rint(rev));
    cs = __builtin_amdgcn_cosf(fr); sn = __builtin_amdgcn_sinf(fr);
    asm volatile("" : "+v"(cs), "+v"(sn));
}

namespace pg8 {
constexpr int BM = 256, BK = 64, HALF = 128, HTB = HALF * BK * 2, STAGE_BYTES = 8 * HTB, NXCD = 8, WGM = 8;
__device__ __forceinline__ int lds_byte(int r, int c) { const int st = (r >> 4) * 2 + (c >> 5), rr = r & 15, cc = c & 31, ob = rr * 64 + cc * 2; return st * 1024 + (ob ^ (((ob >> 9) & 1) << 5)); }
__device__ __forceinline__ void stage_rc(int b, int& R, int& C) { const int st = b / 1024, sb = b % 1024, swz = sb ^ (((sb >> 9) & 1) << 5); R = (st >> 1) * 16 + swz / 64; C = (st & 1) * 32 + (swz % 64) / 2; }
__device__ __forceinline__ int perm32(int rho) { const int n = rho >> 4, i = rho & 15; return 8 * (i >> 2) + 4 * n + (i & 3); }
struct Unit { int pm, pn; };
struct Gemm { const bf16_t* A; const bf16_t* Bt; int M, N, K, lda, ldb; };
struct StaticOrder {
    int nM, nN, nwg, G, c;
    __device__ void init(int M, int N, int G_, int c_) { nM = M / BM; nN = N / BM; nwg = nM * nN; G = G_; c = c_; }
    __device__ bool next(int i, Unit& u) const {
        const long L = (long)i * G + c; if (L >= nwg) return false;
        int wgid = (int)L; { const int q = nwg / NXCD, r = nwg % NXCD, xcd = wgid % NXCD, off = wgid / NXCD; wgid = (xcd < r ? xcd * (q + 1) : r * (q + 1) + (xcd - r) * q) + off; }
        const int nig = WGM * nN, gid = wgid / nig, fm = gid * WGM, gsz = (nM - fm) < WGM ? (nM - fm) : WGM;
        u.pm = fm + ((wgid % nig) % gsz); u.pn = (wgid % nig) / gsz; return true;
    }
};
template <class Epi>
__device__ __forceinline__ void gemm_phase(LAS unsigned char* lds, const Gemm g, const StaticOrder& S, const Epi& E, int wave_s) {
    const int tid = wave_s * 64 + lane_now(), wid = __builtin_amdgcn_readfirstlane(tid >> 6), lane = tid & 63, wr = wid >> 2, wc = wid & 3, fr = lane & 15, fq = lane >> 4;
    const int K = g.K, nt = K / BK;
    unsigned voffA[2], voffB[2];
#pragma unroll
    for (int i = 0; i < 2; ++i) { int R, C; stage_rc(tid * 16 + i * 8192, R, C); const int Rb = (R & ~31) + perm32(R & 31);
        voffA[i] = (unsigned)(R * g.lda + C) * 2u; voffB[i] = (unsigned)(Rb * g.ldb + C) * 2u; }
    const size_t kstep = (size_t)(BK * 2);
    const size_t hstepA = (size_t)HALF * g.lda * 2, hstepB = (size_t)HALF * g.ldb * 2;
    const size_t tstepA = 2 * hstepA, tstepB = 2 * hstepB;
    const unsigned ldsw = (unsigned)wid * 1024u;
    const int aoff = lds_byte(wr * 64 + fr, fq * 8), boff = lds_byte(wc * 32 + fr, fq * 8);
#define PG8_SA(b, h) (((b) * 2 + (h)) * HTB)
#define PG8_SB(b, h) ((4 + (b) * 2 + (h)) * HTB)
#define PG8_STAGE(bufoff, gbase, voff) do { _Pragma("unroll") for (int _i = 0; _i < 2; ++_i) \
        __builtin_amdgcn_global_load_lds((const unsigned*)((const char*)(gbase) + (voff)[_i]), (LAS unsigned*)(lds + (bufoff) + ldsw + _i * 8192), 16, 0, 0); } while (0)
#define PG8_LDA(dst, b, h) do { _Pragma("unroll") for (int m = 0; m < 4; ++m) _Pragma("unroll") for (int k = 0; k < 2; ++k) dst[m][k] = *(const LAS bf16x8*)(lds + PG8_SA(b, h) + aoff + m * 2048 + k * 1024); } while (0)
#define PG8_LDB(dst, b, h) do { _Pragma("unroll") for (int n = 0; n < 2; ++n) _Pragma("unroll") for (int k = 0; k < 2; ++k) dst[n][k] = *(const LAS bf16x8*)(lds + PG8_SB(b, h) + boff + n * 2048 + k * 1024); } while (0)
#define PG8_MMA(ai, bj, At, Bt) do { __builtin_amdgcn_s_setprio(1); _Pragma("unroll") for (int m = 0; m < 4; ++m) _Pragma("unroll") for (int n = 0; n < 2; ++n) _Pragma("unroll") for (int k = 0; k < 2; ++k) \
        acc[ai][bj][m][n] = __builtin_amdgcn_mfma_f32_16x16x32_bf16(Bt[n][k], At[m][k], acc[ai][bj][m][n], 0, 0, 0); __builtin_amdgcn_s_setprio(0); } while (0)
#define PG8_WAIT_V(n) asm volatile("s_waitcnt vmcnt(" #n ")" ::: "memory")
#define PG8_WAIT_L(n) asm volatile("s_waitcnt lgkmcnt(" #n ")" ::: "memory")
#define PG8_BAR __builtin_amdgcn_s_barrier()
#define PG8_SCHED __builtin_amdgcn_sched_barrier(0)
    Unit cur, nxt; int ui = 0;
    if (!S.next(0, cur)) return;
    f32x4 acc[2][2][4][2];
#pragma unroll
    for (int a = 0; a < 2; ++a)
#pragma unroll
        for (int b = 0; b < 2; ++b)
#pragma unroll
            for (int m = 0; m < 4; ++m)
#pragma unroll
                for (int n = 0; n < 2; ++n) acc[a][b][m][n] = (f32x4){0.f, 0.f, 0.f, 0.f};
    bf16x8 At[4][2], B0[2][2], B1[2][2];
    const char* cA = (const char*)g.A + (size_t)cur.pm * tstepA; const char* cB = (const char*)g.Bt + (size_t)cur.pn * tstepB;
    PG8_STAGE(PG8_SB(0, 0), cB, voffB); PG8_STAGE(PG8_SB(0, 1), cB + hstepB, voffB); PG8_STAGE(PG8_SA(0, 0), cA, voffA); PG8_STAGE(PG8_SA(0, 1), cA + hstepA, voffA);
    if (wr == 1) PG8_BAR;
    PG8_WAIT_V(2); PG8_BAR;
    PG8_STAGE(PG8_SB(1, 0), cB + kstep, voffB); PG8_STAGE(PG8_SA(1, 0), cA + kstep, voffA); PG8_STAGE(PG8_SB(1, 1), cB + hstepB + kstep, voffB);
    PG8_WAIT_V(6); PG8_BAR;
    for (;;) {
        const bool has_next = S.next(ui + 1, nxt);
        const char* nA = has_next ? (const char*)g.A + (size_t)nxt.pm * tstepA : cA; const char* nB = has_next ? (const char*)g.Bt + (size_t)nxt.pn * tstepB : cB;
        for (int t = 0; t < nt; t += 2) {
            const bool last = (t == nt - 2);
            const char* a1 = cA + (size_t)(t + 1) * kstep;
            const char* a2 = last ? nA : cA + (size_t)(t + 2) * kstep; const char* b2 = last ? nB : cB + (size_t)(t + 2) * kstep;
            const char* a3 = a2 + kstep; const char* b3 = b2 + kstep;
            PG8_LDB(B0, 0, 0); PG8_LDB(B1, 0, 1); PG8_SCHED; PG8_LDA(At, 0, 0); PG8_STAGE(PG8_SA(1, 1), a1 + hstepA, voffA);
            PG8_WAIT_V(8); PG8_WAIT_L(0); PG8_BAR; PG8_MMA(0, 0, At, B0); PG8_MMA(0, 1, At, B1); PG8_BAR; PG8_SCHED;
            PG8_LDA(At, 0, 1); PG8_STAGE(PG8_SB(0, 0), b2, voffB); PG8_STAGE(PG8_SB(0, 1), b2 + hstepB, voffB); PG8_STAGE(PG8_SA(0, 0), a2, voffA);
            PG8_WAIT_V(8); PG8_WAIT_L(0); PG8_BAR; PG8_MMA(1, 0, At, B0); PG8_MMA(1, 1, At, B1); PG8_BAR; PG8_SCHED;
            PG8_LDB(B0, 1, 0); PG8_LDB(B1, 1, 1); PG8_SCHED; PG8_LDA(At, 1, 0); PG8_STAGE(PG8_SA(0, 1), a2 + hstepA, voffA);
            PG8_WAIT_V(8); PG8_WAIT_L(0); PG8_BAR; PG8_MMA(0, 0, At, B0); PG8_MMA(0, 1, At, B1); PG8_BAR; PG8_SCHED;
            PG8_LDA(At, 1, 1); PG8_STAGE(PG8_SB(1, 0), b3, voffB); PG8_STAGE(PG8_SB(1, 1), b3 + hstepB, voffB); PG8_STAGE(PG8_SA(1, 0), a3, voffA);
            PG8_WAIT_V(8); PG8_WAIT_L(0); PG8_BAR; PG8_MMA(1, 0, At, B0); PG8_MMA(1, 1, At, B1); PG8_BAR; PG8_SCHED;
        }
        if (wr == 0) PG8_BAR;
        E(acc, cur, wr, wc, fr, fq);
        if (!has_next) break;
#pragma unroll
        for (int a = 0; a < 2; ++a)
#pragma unroll
            for (int b = 0; b < 2; ++b)
#pragma unroll
                for (int m = 0; m < 4; ++m)
#pragma unroll
                    for (int n = 0; n < 2; ++n) acc[a][b][m][n] = (f32x4){0.f, 0.f, 0.f, 0.f};
        cur = nxt; cA = nA; cB = nB; ++ui;
        if (wr == 1) PG8_BAR;
    }
    PG8_WAIT_V(0);
    PG8_BAR;
#undef PG8_SA
#undef PG8_SB
#undef PG8_STAGE
#undef PG8_LDA
#undef PG8_LDB
#undef PG8_MMA
#undef PG8_WAIT_V
#undef PG8_WAIT_L
#undef PG8_BAR
#undef PG8_SCHED
}

struct EpiSwiGLU {
    bf16_t* H; const float* ssq;
    __device__ __forceinline__ void operator()(const f32x4 (&acc)[2][2][4][2], const Unit& u, int wr, int wc, int fr, int fq) const {
        const int row0 = u.pm * BM + wr * 64 + fr, col0 = u.pn * 128 + wc * 32 + 8 * fq;
#pragma unroll
        for (int ai = 0; ai < 2; ++ai)
#pragma unroll
            for (int m = 0; m < 4; ++m) {
                const int row = row0 + ai * HALF + m * 16;
                const float rs = 1.0f / sqrtf(ssq_sum(ssq + (size_t)row * 16) * (1.0f / DM) + EPS);
                float hv[8];
#pragma unroll
                for (int n = 0; n < 2; ++n)
#pragma unroll
                    for (int e = 0; e < 4; ++e) {
                        const float gg = acc[ai][0][m][n][e] * rs, uu = acc[ai][1][m][n][e] * rs;
                        const float den = 1.0f + __builtin_amdgcn_exp2f(-gg * LOG2E);
                        hv[n * 4 + e] = gg * uu * __builtin_amdgcn_rcpf(den);
                    }
                u32x4 w; w.x = cvtpk(hv[0], hv[1]); w.y = cvtpk(hv[2], hv[3]); w.z = cvtpk(hv[4], hv[5]); w.w = cvtpk(hv[6], hv[7]);
                *(u32x4*)(H + (size_t)row * DFF + col0) = w;
            }
    }
};
template <int RM> struct EpiResidB {
    const float* xf; float* outf; bf16_t* xb; float* ssq_out; float alpha;
    __device__ __forceinline__ void operator()(const f32x4 (&acc)[2][2][4][2], const Unit& u, int wr, int wc, int fr, int fq) const {
        const int row0 = u.pm * BM + wr * 64 + fr, col0 = u.pn * BM + wc * 32 + 8 * fq;
        u32x4 xv[RM == 0 ? 1 : 2][RM == 0 ? 1 : 4][RM == 0 ? 1 : 2];
        if (RM != 0) {
#pragma unroll
            for (int ai = 0; ai < 2; ++ai)
#pragma unroll
                for (int m = 0; m < 4; ++m)
#pragma unroll
                    for (int bj = 0; bj < 2; ++bj) xv[RM == 0 ? 0 : ai][RM == 0 ? 0 : m][RM == 0 ? 0 : bj] = *(const u32x4*)(xb + (size_t)(row0 + ai * HALF + m * 16) * DM + col0 + bj * HALF);
        }
#pragma unroll
        for (int ai = 0; ai < 2; ++ai)
#pragma unroll
            for (int m = 0; m < 4; ++m) {
                const int row = row0 + ai * HALF + m * 16; float s = 0.f;
#pragma unroll
                for (int bj = 0; bj < 2; ++bj) {
                    const size_t off = (size_t)row * DM + col0 + bj * HALF;
                    f32x4 v0, v1;
                    if (RM == 0) { v0 = *(const f32x4*)(xf + off); v1 = *(const f32x4*)(xf + off + 4); }
                    else { const u32x4 w = xv[RM == 0 ? 0 : ai][RM == 0 ? 0 : m][RM == 0 ? 0 : bj]; v0 = (f32x4){bflo(w.x), bfhi(w.x), bflo(w.y), bfhi(w.y)}; v1 = (f32x4){bflo(w.z), bfhi(w.z), bflo(w.w), bfhi(w.w)}; }
                    v0 = v0 + acc[ai][bj][m][0] * alpha; v1 = v1 + acc[ai][bj][m][1] * alpha;
                    if (RM == 2) { *(f32x4*)(outf + off) = v0; *(f32x4*)(outf + off + 4) = v1; }
                    else {
                        u32x4 w; w.x = cvtpk(v0[0], v0[1]); w.y = cvtpk(v0[2], v0[3]); w.z = cvtpk(v1[0], v1[1]); w.w = cvtpk(v1[2], v1[3]);
                        *(u32x4*)(xb + off) = w;
                        s += (v0[0] * v0[0] + v0[1] * v0[1]) + (v0[2] * v0[2] + v0[3] * v0[3]) + (v1[0] * v1[0] + v1[1] * v1[1]) + (v1[2] * v1[2] + v1[3] * v1[3]);
                    }
                }
                if (RM != 2) { s += __shfl_xor(s, 16); s += __shfl_xor(s, 32); if (fq == 0) ssq_out[(size_t)row * 16 + u.pn * 4 + wc] = s; }
            }
    }
};
struct EpiOut {
    bf16_t* O; int ldc; const float* ssq_in; float inv_dim; int hd_in, hd_out; float* ssq_o[4];
    __device__ __forceinline__ void operator()(const f32x4 (&acc)[2][2][4][2], const Unit& u, int wr, int wc, int fr, int fq) const {
        const int row0 = u.pm * BM + wr * 64 + fr, col0 = u.pn * BM + wc * 32 + 8 * fq;
        float* so = (u.pn == 0) ? ssq_o[0] : (u.pn == 1) ? ssq_o[1] : (u.pn == 2) ? ssq_o[2] : (u.pn == 3) ? ssq_o[3] : nullptr;
#pragma unroll
        for (int ai = 0; ai < 2; ++ai)
#pragma unroll
            for (int m = 0; m < 4; ++m) {
                const int row = row0 + ai * HALF + m * 16; float s = 0.f;
                const float rs = ssq_in ? 1.0f / sqrtf(ssq_sum(ssq_in + (size_t)row * 16) * inv_dim + EPS) : 1.0f;
#pragma unroll
                for (int bj = 0; bj < 2; ++bj) {
                    int col = col0 + bj * HALF; if (hd_in) col = (col / hd_in) * hd_out + (col % hd_in);
                    const f32x4 v0 = acc[ai][bj][m][0] * rs, v1 = acc[ai][bj][m][1] * rs;
                    u32x4 w; w.x = cvtpk(v0[0], v0[1]); w.y = cvtpk(v0[2], v0[3]); w.z = cvtpk(v1[0], v1[1]); w.w = cvtpk(v1[2], v1[3]);
                    *(u32x4*)(O + (size_t)row * ldc + col) = w;
                    s += (v0[0] * v0[0] + v0[1] * v0[1]) + (v0[2] * v0[2] + v0[3] * v0[3]) + (v1[0] * v1[0] + v1[1] * v1[1]) + (v1[2] * v1[2] + v1[3] * v1[3]);
                }
                if (so) { s += __shfl_xor(s, 16); s += __shfl_xor(s, 32); if (fq == 0) so[(size_t)row * 16 + (u.pn & 1) * 4 + wc] = s; }
            }
    }
};
struct EpiOutT {
    bf16_t* O; int ldc; const float* ssq_in; float inv_dim;
    __device__ __forceinline__ void operator()(const f32x4 (&acc)[2][2][4][2], const Unit& u, int wr, int wc, int fr, int fq) const {
        const int row0 = u.pm * BM + wr * 64 + fr, col0 = u.pn * BM + wc * 32 + 8 * fq;
        f32x4 cs[2][2];
#pragma unroll
        for (int bj = 0; bj < 2; ++bj)
#pragma unroll
            for (int n = 0; n < 2; ++n) {
#pragma unroll
                for (int e = 0; e < 4; ++e) cs[bj][n][e] = 1.0f / sqrtf(ssq_sum(ssq_in + (size_t)(col0 + bj * HALF + 4 * n + e) * 16) * inv_dim + EPS); }
#pragma unroll
        for (int ai = 0; ai < 2; ++ai)
#pragma unroll
            for (int m = 0; m < 4; ++m) {
                const int row = row0 + ai * HALF + m * 16;
#pragma unroll
                for (int bj = 0; bj < 2; ++bj) {
                    const f32x4 v0 = acc[ai][bj][m][0] * cs[bj][0], v1 = acc[ai][bj][m][1] * cs[bj][1];
                    u32x4 w; w.x = cvtpk(v0[0], v0[1]); w.y = cvtpk(v0[2], v0[3]); w.z = cvtpk(v1[0], v1[1]); w.w = cvtpk(v1[2], v1[3]);
                    *(u32x4*)(O + (size_t)row * ldc + col0 + bj * HALF) = w;
                }
            }
    }
};

struct EpiQK0 {
    bf16_t* O; const float* ssq_in; const float* gq; const float* gk; float qscale;
    __device__ __forceinline__ void operator()(const f32x4 (&acc)[2][2][4][2], const Unit& u, int wr, int wc, int fr, int fq) const {
        { const int l_ = lane_now(); fq = l_ >> 4; fr = l_ & 15; }
        const int row0 = u.pm * BM + wr * 64 + fr;
        if (u.pn >= 4) {
            const int col0 = u.pn * BM + wc * 32 + 8 * fq;
#pragma unroll
            for (int ai = 0; ai < 2; ++ai)
#pragma unroll
                for (int m = 0; m < 4; ++m) {
                    const int row = row0 + ai * HALF + m * 16;
                    const float rs = (u.pn < 6 ? qscale : 1.0f) / sqrtf(ssq_sum(ssq_in + (size_t)row * 16) * (1.0f / DM) + EPS);
#pragma unroll
                    for (int bj = 0; bj < 2; ++bj) {
                        const f32x4 v0 = acc[ai][bj][m][0] * rs, v1 = acc[ai][bj][m][1] * rs;
                        u32x4 w; w.x = cvtpk(v0[0], v0[1]); w.y = cvtpk(v0[2], v0[3]); w.z = cvtpk(v1[0], v1[1]); w.w = cvtpk(v1[2], v1[3]);
                        *(u32x4*)(O + (size_t)row * 2048 + col0 + bj * HALF) = w;
                    }
                }
            return;
        }
        const int head = u.pn * 4 + wc;
        const float* g = (head < 8 ? gq : gk) + 8 * fq;
        f32x4 gv[2][2];
#pragma unroll
        for (int bj = 0; bj < 2; ++bj)
#pragma unroll
            for (int n = 0; n < 2; ++n) gv[bj][n] = *(const f32x4*)(g + bj * 32 + 4 * n);
#pragma unroll
        for (int ai = 0; ai < 2; ++ai)
#pragma unroll
            for (int m = 0; m < 4; ++m) {
                const int row = row0 + ai * HALF + m * 16; const int pos = row & (SEQ - 1);
                float s = 0.f;
#pragma unroll
                for (int bj = 0; bj < 2; ++bj)
#pragma unroll
                    for (int n = 0; n < 2; ++n) { const f32x4 v = acc[ai][bj][m][n]; s += (v[0] * v[0] + v[1] * v[1]) + (v[2] * v[2] + v[3] * v[3]); }
                s += __shfl_xor(s, 16); s += __shfl_xor(s, 32);
                const float rx = 1.0f / sqrtf(ssq_sum(ssq_in + (size_t)row * 16) * (1.0f / DM) + EPS);
                const float rs = (head < 8 ? qscale : 1.0f) * rx / sqrtf(s * rx * rx * (1.0f / 64.0f) + EPS);
                float o1[8], o2[8];
#pragma unroll
                for (int n = 0; n < 2; ++n)
#pragma unroll
                    for (int e = 0; e < 4; ++e) {
                        float cs, sn; rope_cs(pos, 8 * fq + 4 * n + e, cs, sn);
                        const float x1 = acc[ai][0][m][n][e] * rs * gv[0][n][e], x2 = acc[ai][1][m][n][e] * rs * gv[1][n][e];
                        o1[4 * n + e] = x1 * cs - x2 * sn; o2[4 * n + e] = x1 * sn + x2 * cs;
                    }
                bf16_t* op = O + (size_t)row * 2048 + head * 64 + 8 * fq;
                u32x4 w; w.x = cvtpk(o1[0], o1[1]); w.y = cvtpk(o1[2], o1[3]); w.z = cvtpk(o1[4], o1[5]); w.w = cvtpk(o1[6], o1[7]);
                *(u32x4*)op = w;
                w.x = cvtpk(o2[0], o2[1]); w.y = cvtpk(o2[2], o2[3]); w.z = cvtpk(o2[4], o2[5]); w.w = cvtpk(o2[6], o2[7]);
                *(u32x4*)(op + 32) = w;
                asm volatile("" ::: "memory");
            }
    }
};
struct EpiK1 {
    bf16_t* O; const bf16_t* T1; const float* ssq_in; const float* gk;
    __device__ __forceinline__ void operator()(const f32x4 (&acc)[2][2][4][2], const Unit& u, int wr, int wc, int fr, int fq) const {
        { const int l_ = lane_now(); fq = l_ >> 4; fr = l_ & 15; }
        const int row0 = u.pm * BM + wr * 64 + fr;
        const int head = u.pn * 4 + wc;
        float rhs[8];
#pragma unroll
        for (int ai = 0; ai < 2; ++ai)
#pragma unroll
            for (int m = 0; m < 4; ++m) {
                const int row = row0 + ai * HALF + m * 16;
                const float rkv = 1.0f / sqrtf(ssq_sum(ssq_in + (size_t)row * 16) * (1.0f / 256.0f) + EPS);
                const u32x4 kw = *(const u32x4*)(T1 + (size_t)row * 1024 + 768 + 8 * fq);
                float s = (bflo(kw.x) * bflo(kw.x) + bfhi(kw.x) * bfhi(kw.x)) + (bflo(kw.y) * bflo(kw.y) + bfhi(kw.y) * bfhi(kw.y))
                        + (bflo(kw.z) * bflo(kw.z) + bfhi(kw.z) * bfhi(kw.z)) + (bflo(kw.w) * bflo(kw.w) + bfhi(kw.w) * bfhi(kw.w));
#pragma unroll
                for (int bj = 0; bj < 2; ++bj)
#pragma unroll
                    for (int n = 0; n < 2; ++n) { const f32x4 v = acc[ai][bj][m][n] * rkv; s += (v[0] * v[0] + v[1] * v[1]) + (v[2] * v[2] + v[3] * v[3]); }
                s += __shfl_xor(s, 16); s += __shfl_xor(s, 32);
                const float rh = 1.0f / sqrtf(s * (1.0f / 96.0f) + EPS), rs = rkv * rh;
                rhs[ai * 4 + m] = rh;
                bf16_t* op = O + (size_t)row * 1536 + head * 96;
#pragma unroll
                for (int bj = 0; bj < 2; ++bj) {
                    const f32x4 g0 = *(const f32x4*)(gk + bj * 32 + 8 * fq), g1 = *(const f32x4*)(gk + bj * 32 + 8 * fq + 4);
                    const f32x4 v0 = acc[ai][bj][m][0] * rs * g0, v1 = acc[ai][bj][m][1] * rs * g1;
                    u32x4 w; w.x = cvtpk(v0[0], v0[1]); w.y = cvtpk(v0[2], v0[3]); w.z = cvtpk(v1[0], v1[1]); w.w = cvtpk(v1[2], v1[3]);
                    *(u32x4*)(op + bj * 32 + 8 * fq) = w;
                }
                asm volatile("" ::: "memory");
            }
        const f32x4 gr0 = *(const f32x4*)(gk + 64 + 8 * fq), gr1 = *(const f32x4*)(gk + 64 + 8 * fq + 4);
#pragma unroll
        for (int ai = 0; ai < 2; ++ai)
#pragma unroll
            for (int m = 0; m < 4; ++m) {
                const int row = row0 + ai * HALF + m * 16; const int pos = row & (SEQ - 1);
                const float rh = rhs[ai * 4 + m];
                const u32x4 kw = *(const u32x4*)(T1 + (size_t)row * 1024 + 768 + 8 * fq);
                const float kr[8] = {bflo(kw.x), bfhi(kw.x), bflo(kw.y), bfhi(kw.y), bflo(kw.z), bfhi(kw.z), bflo(kw.w), bfhi(kw.w)};
                float ro[8];
#pragma unroll
                for (int j = 0; j < 8; ++j) {
                    const float x = kr[j] * rh * (j < 4 ? gr0[j & 3] : gr1[j & 3]);
                    const float px = __shfl_xor(x, 32);
                    float cs, sn; rope_cs(pos, 2 * (8 * (fq & 1) + j), cs, sn);
                    ro[j] = (fq < 2) ? (x * cs - px * sn) : (px * sn + x * cs);
                }
                u32x4 w; w.x = cvtpk(ro[0], ro[1]); w.y = cvtpk(ro[2], ro[3]); w.z = cvtpk(ro[4], ro[5]); w.w = cvtpk(ro[6], ro[7]);
                *(u32x4*)(O + (size_t)row * 1536 + head * 96 + 64 + 8 * fq) = w;
                asm volatile("" ::: "memory");
            }
    }
};
}

__device__ __forceinline__ void swap32(float x, float& lo, float& hi_) {
    auto rr = __builtin_amdgcn_permlane32_swap(__float_as_uint(x), __float_as_uint(x), false, false);
    lo = __uint_as_float(rr[0]); hi_ = __uint_as_float(rr[1]);
}
template <int DQK, int DV, int MODE, int QPRE, bool DIFF>
__device__ __forceinline__ void attn_unit(LAS unsigned char* lds, const bf16_t* __restrict__ Q, int ldq, const bf16_t* __restrict__ Kp0, int ldk,
                                          const bf16_t* __restrict__ VT, int ldvt, bf16_t* __restrict__ O, int ldo, int q0, int nkt, float c  ,
                                          const float* __restrict__ qg, const float* __restrict__ subln, float lam, float post, int wave_s) {
    constexpr int KST = DQK * 2 + 16, VST = 144, KBUF = 64 * KST, VBUF = DV * VST, BUF = KBUF + VBUF;
    constexpr int KCH = DQK / 8, NKC = 64 * KCH, NKL = (NKC + 511) / 512, NVC = DV * 8, NVL = NVC / 512, ND0 = DQK / 16, NDB = DV / 32;
    static_assert(BUF % 16 == 0 && (DV == 64 ? 4 : 2) * BUF <= 131072, "lds");
    const int lane = lane_now(), wid = wave_s, tid = wid * 64 + lane, l32 = lane & 31, hi = lane >> 5;
    LAS unsigned* o1l = (LAS unsigned*)(lds + 65536 + wid * 8192) + lane;
    static_assert(!DIFF || 2 * BUF <= 65536, "o1 park");
    const int my_last = (MODE == 2) ? (nkt - 1) : ((q0 + wid * 32) >> 6);
#pragma unroll 1
    for (int mp = 0; mp < (DIFF ? 2 : 1); ++mp) {
    const bf16_t* Kp = Kp0 + mp * 256;
    bf16x8 qf[ND0];
    { const bf16_t* qrow = Q + mp * 256 + (size_t)(q0 + wid * 32 + l32) * ldq + hi * 8;
#pragma unroll
      for (int d0 = 0; d0 < ND0; ++d0) qf[d0] = *(const bf16x8*)(qrow + d0 * 16); }
    if (QPRE != 0) {
        float v[ND0][8]; float s = 0.f;
#pragma unroll
        for (int d0 = 0; d0 < ND0; ++d0)
#pragma unroll
            for (int j = 0; j < 8; ++j) { v[d0][j] = bf2f((unsigned short)qf[d0][j]); s += v[d0][j] * v[d0][j]; }
        { float a, b; swap32(s, a, b); s = a + b; }
        const float rs = 1.0f / sqrtf(s * (1.0f / DQK) + EPS);
#pragma unroll
        for (int d0 = 0; d0 < ND0; ++d0) { const f32x4 g0 = *(const f32x4*)(qg + d0 * 16 + hi * 8), g1 = *(const f32x4*)(qg + d0 * 16 + hi * 8 + 4);
#pragma unroll
            for (int j = 0; j < 4; ++j) { v[d0][j] *= rs * c * g0[j]; v[d0][4 + j] *= rs * c * g1[j]; } }
        if (QPRE == 3) {
            const int pos = q0 + wid * 32 + l32;
#pragma unroll
            for (int j = 0; j < 8; ++j) { float cs, sn; rope_cs(pos, 2 * (8 * hi + j), cs, sn); const float x1 = v[ND0 - 2][j], x2 = v[ND0 - 1][j];
                v[ND0 - 2][j] = x1 * cs - x2 * sn; v[ND0 - 1][j] = x1 * sn + x2 * cs; }
        }
#pragma unroll
        for (int d0 = 0; d0 < ND0; ++d0) { u32x4 w; w.x = cvtpk(v[d0][0], v[d0][1]); w.y = cvtpk(v[d0][2], v[d0][3]); w.z = cvtpk(v[d0][4], v[d0][5]); w.w = cvtpk(v[d0][6], v[d0][7]); qf[d0] = __builtin_bit_cast(bf16x8, w); }
    }
    f32x16 o[NDB];
#pragma unroll
    for (int i = 0; i < NDB; ++i)
#pragma unroll
        for (int r = 0; r < 16; ++r) o[i][r] = 0.f;
    float mhat = 0.f, l_run = 0.f, Rp = 1.0f;
    bool sb_done = false;
    f32x16 negm;
#pragma unroll
    for (int r = 0; r < 16; ++r) negm[r] = 0.f;
    constexpr bool DEEP = (DV == 64);
    u32x4 kreg[DEEP ? 4 : 1][NKL], vreg[DEEP ? 4 : 1][NVL];
#define ATT_TILE(i) ((MODE == 1) ? (nkt - 1 - (i)) : (i))
    unsigned kof[NKL], vof[NVL];
#pragma unroll
    for (int j = 0; j < NKL; ++j) { const int ci = tid + 512 * j; const int row = ci / KCH, cc = ci % KCH; kof[j] = (unsigned)(row * ldk + cc * 8); }
#pragma unroll
    for (int j = 0; j < NVL; ++j) { const int ci = tid + 512 * j; const int d = ci >> 3, cc = ci & 7; vof[j] = (unsigned)(d * ldvt + cc * 8); }
#define ATT_LOADG(t, rs) do { const bf16_t* kt_ = Kp + (size_t)(t) * 64 * ldk; const bf16_t* vt_ = VT + (size_t)(t) * 64; \
    _Pragma("unroll") for (int j = 0; j < NKL; ++j) { const int ci = tid + 512 * j; if (NKC % 512 == 0 || ci < NKC) kreg[rs][j] = *(const u32x4*)(kt_ + kof[j]); } \
    _Pragma("unroll") for (int j = 0; j < NVL; ++j) vreg[rs][j] = *(const u32x4*)(vt_ + vof[j]); } while (0)
#define ATT_STORE(b, rs) do { LAS unsigned char* kb_ = lds + (b) * BUF; LAS unsigned char* vb_ = kb_ + KBUF; \
    _Pragma("unroll") for (int j = 0; j < NKL; ++j) { const int ci = tid + 512 * j; if (NKC % 512 == 0 || ci < NKC) { const int row = ci / KCH, cc = ci % KCH; \
        *(LAS u32x4*)(kb_ + row * KST + cc * 16) = kreg[rs][j]; } } \
    _Pragma("unroll") for (int j = 0; j < NVL; ++j) { const int ci = tid + 512 * j; const int d = ci >> 3, cc = ci & 7; \
        *(LAS u32x2*)(vb_ + d * VST + (cc >> 1) * 32 + (cc & 1) * 8) = (u32x2){vreg[rs][j].x, vreg[rs][j].y}; *(LAS u32x2*)(vb_ + d * VST + (cc >> 1) * 32 + (cc & 1) * 8 + 16) = (u32x2){vreg[rs][j].z, vreg[rs][j].w}; } } while (0)
#define ATT_BAR() do { asm volatile("s_waitcnt lgkmcnt(0)" ::: "memory"); __builtin_amdgcn_s_barrier(); asm volatile("" ::: "memory"); } while (0)
    ATT_LOADG(ATT_TILE(0), 0); if (DEEP) { ATT_LOADG(ATT_TILE(1), (DEEP ? 1 : 0)); ATT_LOADG(ATT_TILE(2), (DEEP ? 2 : 0)); ATT_LOADG(ATT_TILE(3), (DEEP ? 3 : 0)); }
    LAS unsigned* sbcnt = (LAS unsigned*)(lds + 131072 + 32);
    if (MODE == 1 && wid == 0 && lane == 0) *sbcnt = 0u;
    bool sb_stop = false;
    ATT_STORE(0, 0); if (DEEP) ATT_STORE(1, (DEEP ? 1 : 0)); ATT_BAR();
    int pp = 0;
    constexpr int UNR = DEEP ? 2 : 1;
    constexpr bool QKFIRST = (MODE == 1);
    constexpr int NPH = DEEP ? 2 : 1;
    for (int i00 = 0; i00 < nkt && !sb_stop; i00 += UNR * NPH) {
#pragma unroll
    for (int ph = 0; ph < NPH; ++ph) {
    const int i0 = i00 + UNR * ph;
    if (!(MODE == 1 && sb_stop)) {
    f32x16 sq[UNR][2];
#pragma unroll
    for (int hf = 0; hf < UNR; ++hf) {
        const int i = i0 + hf;
        const int bi = DEEP ? (pp * 2 + hf) : (i & 1);
        const int t = ATT_TILE(i);
        if (DEEP) { if (hf == 0 && i0 + 4 < nkt) { ATT_LOADG(ATT_TILE(i0 + 4), (DEEP ? 2 * ph : 0)); ATT_LOADG(ATT_TILE(i0 + 5), (DEEP ? 2 * ph + 1 : 0)); } } else { if (i + 1 < nkt) ATT_LOADG(ATT_TILE(i + 1), 0); }
        if (t <= my_last && !(MODE == 1 && sb_done)) {
            const LAS unsigned char* kb = lds + bi * BUF + l32 * KST + hi * 16;
            f32x16& s0 = sq[hf][0]; f32x16& s1 = sq[hf][1];
            if (QKFIRST) {
            {
                const bf16x8 a0 = *(const LAS bf16x8*)(kb), a1 = *(const LAS bf16x8*)(kb + 32 * KST);
                if (MODE == 1) { const f32x16 z16 = {0.f, 0.f, 0.f, 0.f, 0.f, 0.f, 0.f, 0.f, 0.f, 0.f, 0.f, 0.f, 0.f, 0.f, 0.f, 0.f};
                    s0 = __builtin_amdgcn_mfma_f32_32x32x16_bf16(a0, qf[0], z16, 0, 0, 0); s1 = __builtin_amdgcn_mfma_f32_32x32x16_bf16(a1, qf[0], z16, 0, 0, 0); }
                else { s0 = __builtin_amdgcn_mfma_f32_32x32x16_bf16(a0, qf[0], negm, 0, 0, 0); s1 = __builtin_amdgcn_mfma_f32_32x32x16_bf16(a1, qf[0], negm, 0, 0, 0); }
            }
#pragma unroll
            for (int d0 = 1; d0 < ND0; ++d0) {
                const bf16x8 a0 = *(const LAS bf16x8*)(kb + d0 * 32), a1 = *(const LAS bf16x8*)(kb + 32 * KST + d0 * 32);
                s0 = __builtin_amdgcn_mfma_f32_32x32x16_bf16(a0, qf[d0], s0, 0, 0, 0);
                s1 = __builtin_amdgcn_mfma_f32_32x32x16_bf16(a1, qf[d0], s1, 0, 0, 0);
            }
            }
        }
    }
#pragma unroll
    for (int hf = 0; hf < UNR; ++hf) {
        const int i = i0 + hf;
        const int bi = DEEP ? (pp * 2 + hf) : (i & 1);
        const int t = ATT_TILE(i);
        if (t <= my_last && !(MODE == 1 && sb_done)) {
            const LAS unsigned char* vb = lds + bi * BUF + KBUF + l32 * VST + hi * 16;
            f32x16& s0 = sq[hf][0]; f32x16& s1 = sq[hf][1];
            if (!QKFIRST) {
                const LAS unsigned char* kb = lds + bi * BUF + l32 * KST + hi * 16;
            {
                const bf16x8 a0 = *(const LAS bf16x8*)(kb), a1 = *(const LAS bf16x8*)(kb + 32 * KST);
                if (MODE == 1) { const f32x16 z16 = {0.f, 0.f, 0.f, 0.f, 0.f, 0.f, 0.f, 0.f, 0.f, 0.f, 0.f, 0.f, 0.f, 0.f, 0.f, 0.f};
                    s0 = __builtin_amdgcn_mfma_f32_32x32x16_bf16(a0, qf[0], z16, 0, 0, 0); s1 = __builtin_amdgcn_mfma_f32_32x32x16_bf16(a1, qf[0], z16, 0, 0, 0); }
                else { s0 = __builtin_amdgcn_mfma_f32_32x32x16_bf16(a0, qf[0], negm, 0, 0, 0); s1 = __builtin_amdgcn_mfma_f32_32x32x16_bf16(a1, qf[0], negm, 0, 0, 0); }
            }
#pragma unroll
            for (int d0 = 1; d0 < ND0; ++d0) {
                const bf16x8 a0 = *(const LAS bf16x8*)(kb + d0 * 32), a1 = *(const LAS bf16x8*)(kb + 32 * KST + d0 * 32);
                s0 = __builtin_amdgcn_mfma_f32_32x32x16_bf16(a0, qf[d0], s0, 0, 0, 0);
                s1 = __builtin_amdgcn_mfma_f32_32x32x16_bf16(a1, qf[d0], s1, 0, 0, 0);
            }
            }
            bf16x8 vf[2][4];
#define ATT_LOADV(dst, db_) do { const LAS unsigned char* vr_ = vb + (db_) * 32 * VST; _Pragma("unroll") for (int kk = 0; kk < 4; ++kk) dst[kk] = *(const LAS bf16x8*)(vr_ + kk * 32); } while (0)
            ATT_LOADV(vf[0], 0); if (!(DEEP && MODE == 1)) ATT_LOADV(vf[1], 1);
            __builtin_amdgcn_sched_barrier(0);
            if (MODE != 1) {
                float mx = fmaxf(s0[0], s1[0]);
#pragma unroll
                for (int r = 1; r < 16; ++r) mx = fmaxf(fmaxf(mx, s0[r]), s1[r]);
                { float a, b; swap32(mx, a, b); mx = fmaxf(a, b); }
                const bool first = (i == 0);
                if (first || __any(mx > 8.0f)) {
                    const float dl = first ? mx : fmaxf(mx, 0.f);
                    mhat += dl;
#pragma unroll
                    for (int r = 0; r < 16; ++r) { s0[r] -= dl; s1[r] -= dl; negm[r] = -mhat; }
                    if (DEEP && QKFIRST && hf == 0 && (ATT_TILE(i0 + UNR - 1) <= my_last)) {
#pragma unroll
                        for (int r = 0; r < 16; ++r) { sq[UNR - 1][0][r] -= dl; sq[UNR - 1][1][r] -= dl; }
                    }
                    if (!first) {
                        const float alpha = __builtin_amdgcn_exp2f(-dl);
                        l_run *= alpha;
#pragma unroll
                        for (int i2 = 0; i2 < NDB; ++i2)
#pragma unroll
                            for (int r = 0; r < 16; ++r) o[i2][r] *= alpha;
                    }
                }
                float ls = 0.f;
#pragma unroll
                for (int r = 0; r < 16; ++r) { s0[r] = __builtin_amdgcn_exp2f(s0[r]); s1[r] = __builtin_amdgcn_exp2f(s1[r]); ls = fadd_s(ls, fadd_s(s0[r], s1[r])); }
                l_run += ls;
            } else {
                const bool diag = (t == my_last);
                const int qrel = q0 + wid * 32 + l32 - t * 64;
                float kp[32], gprod[8];
#pragma unroll
                for (int k = 0; k < 8; ++k) {
#pragma unroll
                    for (int e = 0; e < 4; ++e) {
                        const int r = (k & 3) * 4 + e;
                        const float z2 = __builtin_amdgcn_fmed3f((k < 4) ? s0[r] : s1[r], -126.0f, 126.0f);
                        const float E = __builtin_amdgcn_exp2f(z2);
                        const float keep = __builtin_amdgcn_rcpf(fadd_s(E, 1.0f)), beta = fmul_s(E, keep);
                        kp[k * 4 + e] = keep;
                        if (k < 4) s0[r] = beta; else s1[r] = beta;
                    }
                }
                if (diag) {
                    asm volatile("" ::: "memory");
#pragma unroll
                    for (int k = 0; k < 8; ++k)
#pragma unroll
                        for (int e = 0; e < 4; ++e) { const int r = (k & 3) * 4 + e; const int kl = (k >> 2) * 32 + e + 8 * (k & 3) + 4 * hi; const bool valid = kl < qrel;
                            kp[k * 4 + e] = valid ? kp[k * 4 + e] : 1.0f; if (k < 4) s0[r] = valid ? s0[r] : 0.f; else s1[r] = valid ? s1[r] : 0.f; }
                }
#pragma unroll
                for (int k = 0; k < 8; ++k) gprod[k] = fmul_s(fmul_s(kp[k * 4], kp[k * 4 + 1]), fmul_s(kp[k * 4 + 2], kp[k * 4 + 3]));
                float base[8]; float suf = 1.0f;
#pragma unroll
                for (int k = 7; k >= 0; --k) { float glo, ghi; swap32(gprod[k], glo, ghi); base[k] = fmul_s(fmul_s(Rp, suf), (hi == 0 ? ghi : 1.0f)); suf = fmul_s(suf, fmul_s(glo, ghi)); }
                Rp *= suf;
                { const bool nd = __all(Rp == 0.0f); if (nd && !sb_done && lane == 0) __hip_atomic_fetch_add(sbcnt, 1u, __ATOMIC_RELAXED, __HIP_MEMORY_SCOPE_WORKGROUP); sb_done = nd; }
#pragma unroll
                for (int k = 0; k < 8; ++k) {
                    const float l3 = base[k], l2 = fmul_s(l3, kp[k * 4 + 3]), l1 = fmul_s(l2, kp[k * 4 + 2]), l0 = fmul_s(l1, kp[k * 4 + 1]);
                    const int r = (k & 3) * 4;
                    if (k < 4) { s0[r] = fmul_s(s0[r], l0); s0[r + 1] = fmul_s(s0[r + 1], l1); s0[r + 2] = fmul_s(s0[r + 2], l2); s0[r + 3] = fmul_s(s0[r + 3], l3); }
                    else       { s1[r] = fmul_s(s1[r], l0); s1[r + 1] = fmul_s(s1[r + 1], l1); s1[r + 2] = fmul_s(s1[r + 2], l2); s1[r + 3] = fmul_s(s1[r + 3], l3); }
                }
            }
            bf16x8 pb[4];
#pragma unroll
            for (int kk = 0; kk < 4; ++kk) {
                u32x4 w;
                if (kk < 2) { const int b = kk * 8; w.x = cvtpk(s0[b], s0[b + 1]); w.y = cvtpk(s0[b + 2], s0[b + 3]); w.z = cvtpk(s0[b + 4], s0[b + 5]); w.w = cvtpk(s0[b + 6], s0[b + 7]); }
                else        { const int b = (kk - 2) * 8; w.x = cvtpk(s1[b], s1[b + 1]); w.y = cvtpk(s1[b + 2], s1[b + 3]); w.z = cvtpk(s1[b + 4], s1[b + 5]); w.w = cvtpk(s1[b + 6], s1[b + 7]); }
                pb[kk] = __builtin_bit_cast(bf16x8, w);
            }
            __builtin_amdgcn_sched_barrier(0);
#pragma unroll
            for (int dbp = 0; dbp < NDB; dbp += 2) {
                if (!(DEEP && MODE == 1)) {
#pragma unroll
                    for (int kk = 0; kk < 4; ++kk) { o[dbp] = __builtin_amdgcn_mfma_f32_32x32x16_bf16(vf[0][kk], pb[kk], o[dbp], 0, 0, 0);
                                                     o[dbp + 1] = __builtin_amdgcn_mfma_f32_32x32x16_bf16(vf[1][kk], pb[kk], o[dbp + 1], 0, 0, 0); }
                } else {
#pragma unroll
                    for (int kk = 0; kk < 4; ++kk) o[dbp] = __builtin_amdgcn_mfma_f32_32x32x16_bf16(vf[0][kk], pb[kk], o[dbp], 0, 0, 0);
                    ATT_LOADV(vf[0], dbp + 1);
#pragma unroll
                    for (int kk = 0; kk < 4; ++kk) o[dbp + 1] = __builtin_amdgcn_mfma_f32_32x32x16_bf16(vf[0][kk], pb[kk], o[dbp + 1], 0, 0, 0);
                }
                if (dbp + 2 < NDB) { ATT_LOADV(vf[0], dbp + 2); ATT_LOADV(vf[1], dbp + 3); }
            }
#undef ATT_LOADV
        }
        if (DEEP) { if (hf == 1) { if (i0 + 2 < nkt) { ATT_STORE((pp ^ 1) * 2, (DEEP ? 2 * (ph ^ 1) : 0)); ATT_STORE((pp ^ 1) * 2 + 1, (DEEP ? 2 * (ph ^ 1) + 1 : 0)); } ATT_BAR(); pp ^= 1;
            if (MODE == 1) { sb_stop = (__builtin_amdgcn_readfirstlane((int)*(volatile LAS unsigned*)sbcnt) >= 8); ATT_BAR(); } } }
        else { if (i + 1 < nkt) ATT_STORE(bi ^ 1, 0); ATT_BAR(); }
    }
    }
    }
    }
    float inv = 1.0f;
    if (MODE != 1) { float a, b; swap32(l_run, a, b); inv = 1.0f / (a + b); }
    if (DIFF && mp == 0) {
#pragma unroll
        for (int db = 0; db < NDB; ++db)
#pragma unroll
            for (int g = 0; g < 8; ++g) o1l[(db * 8 + g) * 64] = cvtpk(o[db][2 * g] * inv, o[db][2 * g + 1] * inv);
        continue;
    }
    bf16_t* orow = O + (size_t)(q0 + wid * 32 + l32) * ldo + 4 * hi;
    if (DIFF) {
        float s = 0.f;
#pragma unroll
        for (int db = 0; db < NDB; ++db)
#pragma unroll
            for (int g = 0; g < 8; ++g) { const unsigned w = o1l[(db * 8 + g) * 64];
                const float a = bflo(w) - lam * (o[db][2 * g] * inv), b = bfhi(w) - lam * (o[db][2 * g + 1] * inv);
                o[db][2 * g] = a; o[db][2 * g + 1] = b; s += a * a + b * b; if (g == 7) asm volatile("" ::: "memory"); }
        { float a, b; swap32(s, a, b); s = a + b; }
        const float rs = post / sqrtf(s * (1.0f / DV) + EPS);
#pragma unroll
        for (int db = 0; db < NDB; ++db)
#pragma unroll
            for (int g = 0; g < 4; ++g) { const f32x4 gn = *(const f32x4*)(subln + db * 32 + 8 * g + 4 * hi);
                u32x2 w; w.x = cvtpk(o[db][4 * g] * rs * gn[0], o[db][4 * g + 1] * rs * gn[1]); w.y = cvtpk(o[db][4 * g + 2] * rs * gn[2], o[db][4 * g + 3] * rs * gn[3]);
                *(u32x2*)(orow + db * 32 + 8 * g) = w; }
    } else {
#pragma unroll
        for (int db = 0; db < NDB; ++db)
#pragma unroll
            for (int g = 0; g < 4; ++g) {
                u32x2 w; w.x = cvtpk(o[db][4 * g] * inv, o[db][4 * g + 1] * inv); w.y = cvtpk(o[db][4 * g + 2] * inv, o[db][4 * g + 3] * inv);
                *(u32x2*)(orow + db * 32 + 8 * g) = w;
            }
    }
    }
#undef ATT_TILE
#undef ATT_LOADG
#undef ATT_STORE
#undef ATT_BAR
}

constexpr size_t MiB = 1u << 20;
constexpr int SSQ_MQ = 8, SSQ_MKV = 9, SSQ_MEM = 10, NSSQ = 11;
constexpr size_t WS_BAR = 1792 * 1024, BAR_BYTES = 16384;
constexpr size_t WS_KMEM = 2 * MiB;
constexpr size_t WS_VTMEM = 6 * MiB;
constexpr size_t WS_MEMB = 10 * MiB;
constexpr size_t WS_W = 16 * MiB;
constexpr size_t SZ_WGU = (size_t)2 * DFF * DM * 2, SZ_WD = (size_t)DM * DFF * 2, SZ_FFN = SZ_WGU + SZ_WD;
constexpr size_t WS_FFN = WS_W;
constexpr size_t WS_WQK0 = WS_FFN + 4 * SZ_FFN;
constexpr size_t WS_WV0 = WS_WQK0 + 4 * MiB;
constexpr size_t WS_WOUT0 = WS_WV0 + 2 * MiB;
constexpr size_t WS_WD1 = WS_WOUT0 + 2 * MiB;
constexpr size_t WS_WUQ = WS_WD1 + 2 * MiB;
constexpr size_t WS_WUKVK = WS_WUQ + 3 * MiB / 2;
constexpr size_t WS_WUKVV = WS_WUKVK + MiB / 2;
constexpr size_t WS_WO1 = WS_WUKVV + MiB / 2;
constexpr size_t WS_XM = WS_WO1 + 2 * MiB;
constexpr size_t WS_XB = 105 * MiB;
static_assert(WS_XM + 8 * MiB <= WS_XB, "weights");
constexpr size_t WS_R1 = 170 * MiB;
constexpr size_t WS_H = WS_R1;
constexpr size_t WS_QK0 = WS_R1;
constexpr size_t WS_VT0 = WS_R1 + 128 * MiB;
constexpr size_t WS_OD0 = WS_R1 + 192 * MiB;
constexpr size_t WS_MIX0 = WS_R1 + 256 * MiB;
constexpr size_t WS_T1 = WS_R1;
constexpr size_t WS_Q1 = WS_R1 + 64 * MiB;
constexpr size_t WS_K1 = WS_R1 + 160 * MiB;
constexpr size_t WS_VT1 = WS_R1 + 256 * MiB;
constexpr size_t WS_O1 = WS_R1;
constexpr size_t WS_XQ = WS_R1;
constexpr size_t WS_XO = WS_R1 + 32 * MiB;
constexpr size_t WS_SSQ = WS_R1 + 320 * MiB;
constexpr size_t WS_END = WS_SSQ + (size_t)NSSQ * MTOK * 16 * 4;
static_assert(WS_END <= 512 * MiB && WS_XB + (size_t)MTOK * DM * 2 <= WS_R1, "ws map");

struct Params { const float* in[32]; float* out; unsigned char* ws; int lo, hi; };

__device__ __forceinline__ float wave_sum(float v) {
#pragma unroll
    for (int o = 1; o < 64; o <<= 1) v += __shfl_xor(v, o);
    return v;
}
__device__ __forceinline__ void prep_decode(int it, int nblk, int mode, bf16_t* d0, bf16_t* d1, int& k0, int& j0, bf16_t*& dst, int& row0) {
    const int kb = it / nblk, nb = it % nblk; k0 = 64 * kb; j0 = 32 * nb;
    dst = d0; row0 = j0;
    switch (mode) {
        case 1: row0 = (j0 >> 7) * 256 + (j0 & 127); break;
        case 2: row0 = (j0 >> 7) * 256 + 128 + (j0 & 127); break;
        case 3: { const int seg = j0 >> 9, r = j0 & 511; if (seg <= 1) { const int hd = j0 >> 6, dd = j0 & 63; row0 = (hd >> 2) * 256 + (dd >> 5) * 128 + (hd & 3) * 32; } else if (seg == 2) { dst = d1; row0 = r; } else if (seg == 3) row0 = 1024 + r; else if (seg == 4) row0 = 1536 + r; else { dst = d1; row0 = 512 + r; } } break;
        case 4: { const int h = j0 >> 7, w = j0 & 127; if (w < 64) row0 = (h >> 2) * 256 + (w >> 5) * 128 + (h & 3) * 32; else { dst = d1; row0 = h * 64 + w - 64; } } break;
        case 5: if (j0 >= 512) { dst = d1; row0 = j0 - 512; } break;
        case 6: row0 = 512 + j0; break;
        default: break;
    }
}
__device__ __forceinline__ void prep_job(const float* __restrict__ W, int Ns, int K, const float* __restrict__ gain, int mode, bf16_t* d0, bf16_t* d1,
                                         LAS float* scr, int gw, int NGW, int lane) {
    const int nblk = Ns / 32, nitems = (K / 64) * nblk;
    const int lr = lane >> 3, lc = (lane & 7) * 4;
    f32x4 ld[8]; float gg[8];
    int it = gw;
#define PREP_LOAD(it_) do { int k0_, j0_, r0_; bf16_t* ds_; prep_decode((it_), nblk, mode, d0, d1, k0_, j0_, ds_, r0_); \
        _Pragma("unroll") for (int i = 0; i < 8; ++i) { const int kk = i * 8 + lr; ld[i] = *(const f32x4*)(W + (size_t)(k0_ + kk) * Ns + j0_ + lc); gg[i] = gain ? gain[k0_ + kk] : 1.0f; } } while (0)
    if (it < nitems) PREP_LOAD(it);
    while (it < nitems) {
        int k0, j0, row0; bf16_t* dst; prep_decode(it, nblk, mode, d0, d1, k0, j0, dst, row0);
#pragma unroll
        for (int i = 0; i < 8; ++i) { const int kk = i * 8 + lr;
#pragma unroll
            for (int e = 0; e < 4; ++e) scr[kk * 33 + lc + e] = ld[i][e] * gg[i]; }
        const int itn = it + NGW;
        if (itn < nitems) PREP_LOAD(itn);
        asm volatile("s_waitcnt lgkmcnt(0)" ::: "memory");
        const int cch = lane & 7;
#pragma unroll
        for (int j = 0; j < 4; ++j) { const int n = (lane >> 3) + 8 * j; const LAS float* s = scr + (8 * cch) * 33 + n;
            u32x4 o; o.x = cvtpk(s[0 * 33], s[1 * 33]); o.y = cvtpk(s[2 * 33], s[3 * 33]); o.z = cvtpk(s[4 * 33], s[5 * 33]); o.w = cvtpk(s[6 * 33], s[7 * 33]);
            *(u32x4*)(dst + (size_t)(row0 + n) * K + k0 + 8 * cch) = o; }
        asm volatile("s_waitcnt lgkmcnt(0)" ::: "memory");
        it = itn;
    }
#undef PREP_LOAD
}
constexpr int PT_W = 0, PT_G = 256, PT_D0 = 512, PT_D1 = 768, PT_NS = 1024, PT_K = 1152, PT_MODE = 1280, PT_START = 1408;
__device__ __forceinline__ int rfl(int v) { return __builtin_amdgcn_readfirstlane(v); }
__device__ __forceinline__ unsigned long long rfl64(unsigned long long v) { return ((unsigned long long)(unsigned)rfl((int)(v >> 32)) << 32) | (unsigned)rfl((int)(unsigned)v); }
__device__ __forceinline__ void prep_addjob(LAS unsigned char* tb, int& nj, int& acc, const float* W, int Ns, int K, const float* gain, int mode, bf16_t* d0, bf16_t* d1) {
    ((LAS unsigned long long*)(tb + PT_W))[nj] = (unsigned long long)W; ((LAS unsigned long long*)(tb + PT_G))[nj] = (unsigned long long)gain;
    ((LAS unsigned long long*)(tb + PT_D0))[nj] = (unsigned long long)d0; ((LAS unsigned long long*)(tb + PT_D1))[nj] = (unsigned long long)d1;
    ((LAS int*)(tb + PT_NS))[nj] = Ns; ((LAS int*)(tb + PT_K))[nj] = K; ((LAS int*)(tb + PT_MODE))[nj] = mode; ((LAS int*)(tb + PT_START))[nj] = acc;
    acc += (K / 64) * (Ns / 32); ++nj; ((LAS int*)(tb + PT_START))[nj] = acc;
}
__device__ __forceinline__ void prep_all(LAS unsigned char* tb, int njobs, LAS float* scr, int gw, int NGW, int lane) {
    LAS int* tStart = (LAS int*)(tb + PT_START);
    const int total = rfl(tStart[njobs]);
    const int lr = lane >> 3, lc = (lane & 7) * 4;
    f32x4 ld[8]; float gg[8];
    int j = 0, k0n = 0, row0n = 0, Kn = 0; bf16_t* dstn = nullptr;
#define PREP_LOAD(it_) do { while ((it_) >= rfl(tStart[j + 1])) ++j; \
        const int loc_ = (it_) - rfl(tStart[j]); const int Ns_ = rfl(((LAS int*)(tb + PT_NS))[j]); Kn = rfl(((LAS int*)(tb + PT_K))[j]); const int mode_ = rfl(((LAS int*)(tb + PT_MODE))[j]); \
        const float* W_ = (const float*)rfl64(((LAS unsigned long long*)(tb + PT_W))[j]); const float* g_ = (const float*)rfl64(((LAS unsigned long long*)(tb + PT_G))[j]); \
        bf16_t* d0_ = (bf16_t*)rfl64(((LAS unsigned long long*)(tb + PT_D0))[j]); bf16_t* d1_ = (bf16_t*)rfl64(((LAS unsigned long long*)(tb + PT_D1))[j]); \
        int j0_; prep_decode(loc_, Ns_ / 32, mode_, d0_, d1_, k0n, j0_, dstn, row0n); \
        _Pragma("unroll") for (int i = 0; i < 8; ++i) { const int kk = i * 8 + lr; ld[i] = *(const f32x4*)(W_ + (size_t)(k0n + kk) * Ns_ + j0_ + lc); gg[i] = g_ ? g_[k0n + kk] : 1.0f; } } while (0)
    int it = gw;
    if (it < total) PREP_LOAD(it);
    while (it < total) {
        const int k0 = k0n, row0 = row0n, K = Kn; bf16_t* dst = dstn;
#pragma unroll
        for (int i = 0; i < 8; ++i) { const int kk = i * 8 + lr;
#pragma unroll
            for (int e = 0; e < 4; ++e) scr[kk * 33 + lc + e] = ld[i][e] * gg[i]; }
        const int itn = it + NGW;
        if (itn < total) PREP_LOAD(itn);
        asm volatile("s_waitcnt lgkmcnt(0)" ::: "memory");
        const int cch = lane & 7;
#pragma unroll
        for (int jj = 0; jj < 4; ++jj) { const int n = (lane >> 3) + 8 * jj; const LAS float* sp = scr + (8 * cch) * 33 + n;
            u32x4 o; o.x = cvtpk(sp[0 * 33], sp[1 * 33]); o.y = cvtpk(sp[2 * 33], sp[3 * 33]); o.z = cvtpk(sp[4 * 33], sp[5 * 33]); o.w = cvtpk(sp[6 * 33], sp[7 * 33]);
            *(u32x4*)(dst + (size_t)(row0 + n) * K + k0 + 8 * cch) = o; }
        asm volatile("s_waitcnt lgkmcnt(0)" ::: "memory");
        it = itn;
    }
#undef PREP_LOAD
}
__device__ __forceinline__ void row_to_bf16(const float* xrow, bf16_t* orow, float* ssq, int lane) {
    const f32x4* xr = (const f32x4*)xrow + lane; float s = 0.f;
    unsigned long long* o8 = (unsigned long long*)orow + lane;
#pragma unroll
    for (int j = 0; j < 4; ++j) { const f32x4 v = xr[64 * j]; s += (v[0] * v[0] + v[1] * v[1]) + (v[2] * v[2] + v[3] * v[3]);
        o8[64 * j] = (unsigned long long)cvtpk(v[0], v[1]) | ((unsigned long long)cvtpk(v[2], v[3]) << 32); }
    s = wave_sum(s);
    if (lane < 16) ssq[lane] = (lane == 0) ? s : 0.f;
}

__device__ __forceinline__ void ld8(const bf16_t* p, float (&v)[8]) { const u32x4 w = *(const u32x4*)p; v[0] = bflo(w.x); v[1] = bfhi(w.x); v[2] = bflo(w.y); v[3] = bfhi(w.y); v[4] = bflo(w.z); v[5] = bfhi(w.z); v[6] = bflo(w.w); v[7] = bfhi(w.w); }
__device__ __forceinline__ void st8(bf16_t* p, const float (&v)[8]) { u32x4 w; w.x = cvtpk(v[0], v[1]); w.y = cvtpk(v[2], v[3]); w.z = cvtpk(v[4], v[5]); w.w = cvtpk(v[6], v[7]); *(u32x4*)p = w; }

__device__ __forceinline__ void pp_l0(bf16_t* QK, const float* gq, const float* gk, int gw, int NGW, int lane) {
    const int sub = lane >> 3, j = lane & 7;
    for (int it = gw; it < MTOK * 2; it += NGW) {
        const int tok = it >> 1, hv = (it & 1) * 8 + sub;
        bf16_t* p = QK + (size_t)tok * 2048 + hv * 64 + j * 8;
        float v[8]; ld8(p, v);
        float s = 0.f;
#pragma unroll
        for (int e = 0; e < 8; ++e) s += v[e] * v[e];
        s += __shfl_xor(s, 1); s += __shfl_xor(s, 2); s += __shfl_xor(s, 4);
        const float rs = 1.0f / sqrtf(s * (1.0f / 64.0f) + EPS);
        const float* g = (hv < 8 ? gq : gk) + j * 8;
#pragma unroll
        for (int e = 0; e < 8; ++e) v[e] = v[e] * rs * g[e];
        const int pos = tok & (SEQ - 1);
        float o[8];
#pragma unroll
        for (int e = 0; e < 8; ++e) {
            const float pv = __shfl_xor(v[e], 4);
            float cs, sn; rope_cs(pos, (j & 3) * 8 + e, cs, sn);
            o[e] = (j < 4) ? (v[e] * cs - pv * sn) : (pv * sn + v[e] * cs);
        }
        st8(p, o);
    }
}
__device__ __forceinline__ void pp_norm128(bf16_t* X, int nvec, const float* g, int gw, int NGW, int lane) {
    const int sub = lane >> 4, j = lane & 15;
    for (int it = gw; it < nvec / 4; it += NGW) {
        bf16_t* p = X + (size_t)(it * 4 + sub) * 128 + j * 8;
        float v[8]; ld8(p, v);
        float s = 0.f;
#pragma unroll
        for (int e = 0; e < 8; ++e) s += v[e] * v[e];
        s += __shfl_xor(s, 1); s += __shfl_xor(s, 2); s += __shfl_xor(s, 4); s += __shfl_xor(s, 8);
        const float rs = 1.0f / sqrtf(s * (1.0f / 128.0f) + EPS);
#pragma unroll
        for (int e = 0; e < 8; ++e) v[e] = v[e] * rs * g[j * 8 + e];
        st8(p, v);
    }
}
__device__ __forceinline__ void pp_combine(const bf16_t* OD, bf16_t* MIX, const float* subln, float lam, float post, int gw, int NGW, int lane) {
    const int sub = lane >> 4, j = lane & 15;
    for (int it = gw; it < MTOK; it += NGW) {
        const bf16_t* p1 = OD + (size_t)it * 1024 + sub * 128 + j * 8;
        float a[8], b[8]; ld8(p1, a); ld8(p1 + 512, b);
        float s = 0.f;
#pragma unroll
        for (int e = 0; e < 8; ++e) { a[e] = a[e] - lam * b[e]; s += a[e] * a[e]; }
        s += __shfl_xor(s, 1); s += __shfl_xor(s, 2); s += __shfl_xor(s, 4); s += __shfl_xor(s, 8);
        const float rs = post / sqrtf(s * (1.0f / 128.0f) + EPS);
#pragma unroll
        for (int e = 0; e < 8; ++e) a[e] = a[e] * rs * subln[j * 8 + e];
        st8(MIX + (size_t)it * 1024 + sub * 128 + j * 8, a);
    }
}
__device__ __forceinline__ void pp_mla(bf16_t* X  , const bf16_t* T1, const float* g, bool isk, int gw, int NGW, int lane) {
    const int sub = lane >> 4, j = lane & 15;
    for (int it = gw; it < MTOK * 4; it += NGW) {
        const int tok = it >> 2, h = (it & 3) * 4 + sub;
        bf16_t* p = X + (size_t)tok * 1536 + h * 96 + j * 8;
        float v[8];
#pragma unroll
        for (int e = 0; e < 8; ++e) v[e] = 0.f;
        if (j < 12) { if (isk && j >= 8) ld8(T1 + (size_t)tok * 1024 + 768 + (j - 8) * 8, v); else ld8(p, v); }
        float s = 0.f;
#pragma unroll
        for (int e = 0; e < 8; ++e) s += v[e] * v[e];
        s += __shfl_xor(s, 1); s += __shfl_xor(s, 2); s += __shfl_xor(s, 4); s += __shfl_xor(s, 8);
        const float rs = 1.0f / sqrtf(s * (1.0f / 96.0f) + EPS);
        const int jj = j < 12 ? j : 0;
#pragma unroll
        for (int e = 0; e < 8; ++e) v[e] = v[e] * rs * g[jj * 8 + e];
        const int pos = tok & (SEQ - 1);
        float o[8];
#pragma unroll
        for (int e = 0; e < 8; ++e) {
            const float pv = __shfl_xor(v[e], 2);
            o[e] = v[e];
            if (j >= 8) { float cs, sn; rope_cs(pos, 2 * ((j & 1) * 8 + e), cs, sn); o[e] = (j < 10) ? (v[e] * cs - pv * sn) : (pv * sn + v[e] * cs); }
        }
        if (j < 12) st8(p, o);
    }
}


#define XB_TMO      128
#define XB_XCNT(j)  (256  + 64 * (j))
#define XB_XSUB(j)  (1280 + 64 * (j))
#define XB_XGEN(j)  (2304 + 64 * (j))
#define XB_TOP      3328
#define XB_TOPGEN   3392
#define XCD_BAR_WORDS 3456
#define XB_SPIN_CAP (1u << 18)
__device__ __forceinline__ unsigned xb_ld(unsigned* p)              { return __hip_atomic_load(p, __ATOMIC_RELAXED, __HIP_MEMORY_SCOPE_AGENT); }
__device__ __forceinline__ unsigned xb_add(unsigned* p, unsigned v) { return __hip_atomic_fetch_add(p, v, __ATOMIC_RELAXED, __HIP_MEMORY_SCOPE_AGENT); }
__device__ __forceinline__ unsigned xb_xcc_id() { return (unsigned)__builtin_amdgcn_s_getreg((3 << 11) | 20) & 0xFu; }
#define XB_SPIN(cond, bar) do { unsigned _sp = 0; while (cond) { __builtin_amdgcn_s_sleep(1); \
    if ((++_sp & 255u) == 0u) { if (xb_ld(&(bar)[XB_TMO])) break; if (_sp > XB_SPIN_CAP) { atomicAdd(&(bar)[XB_TMO], 1u); break; } } } } while (0)
struct XcdBarrier { unsigned* bar; unsigned x; volatile LAS unsigned* st; int wave; };
__device__ __forceinline__ XcdBarrier xcd_barrier_post(unsigned* bar, volatile LAS unsigned* st, int wave_s) {
    XcdBarrier b; b.bar = bar; b.x = xb_xcc_id(); b.st = st; b.wave = wave_s;
    if (wave_s == 0 && lane_now() == 0) (void)xb_add(&bar[XB_XCNT(b.x)], 1u);
    return b;
}
__device__ __forceinline__ void xcd_barrier_complete(unsigned* bar, unsigned x, unsigned& nloc, unsigned& nx) {
    const unsigned G = gridDim.x * gridDim.y * gridDim.z;
    unsigned sum, cnt, mine, sp = 0u;
    for (;;) {
        sum = 0u; cnt = 0u; mine = 0u;
#pragma unroll
        for (unsigned j = 0; j < 16; ++j) { const unsigned c = xb_ld(&bar[XB_XCNT(j)]); sum += c; cnt += (c > 0u) ? 1u : 0u; mine = (j == x) ? c : mine; }
        if (sum == G) break;
        __builtin_amdgcn_s_sleep(1);
        if ((++sp & 255u) == 0u) { if (xb_ld(&bar[XB_TMO])) break; if (sp > XB_SPIN_CAP) { atomicAdd(&bar[XB_TMO], 1u); break; } }
    }
    nloc = mine > 0u ? mine : 1u; nx = cnt > 0u ? cnt : 1u;
}
__device__ __forceinline__ void xcd_barrier(const XcdBarrier& b) {
    asm volatile("s_waitcnt vmcnt(0)" ::: "memory");
    __syncthreads();
    if (b.wave == 0 && lane_now() == 0) {
        unsigned* bar = b.bar;
        __builtin_amdgcn_s_waitcnt(0);
        unsigned nloc = b.st[0], nx = b.st[1];
        if (nloc == 0u) { xcd_barrier_complete(bar, b.x, nloc, nx); b.st[0] = nloc; b.st[1] = nx; }
        const unsigned old = xb_add(&bar[XB_XSUB(b.x)], 1u);
        const unsigned gen = old / nloc;
        if (old + 1u == (gen + 1u) * nloc) {
            __builtin_amdgcn_fence(__ATOMIC_RELEASE, "agent");
            asm volatile("s_waitcnt vmcnt(0)" ::: "memory");
            const unsigned og = xb_add(&bar[XB_TOP], 1u);
            const unsigned tg = og / nx;
            if (og + 1u == (tg + 1u) * nx) xb_add(&bar[XB_TOPGEN], 1u);
            else XB_SPIN(xb_ld(&bar[XB_TOPGEN]) == tg, bar);
            __builtin_amdgcn_fence(__ATOMIC_ACQUIRE, "agent");
            xb_add(&bar[XB_XGEN(b.x)], 1u);
            asm volatile("s_waitcnt vmcnt(0)" ::: "memory");
        } else {
            XB_SPIN(xb_ld(&bar[XB_XGEN(b.x)]) == gen, bar);
            __builtin_amdgcn_fence(__ATOMIC_ACQUIRE, "agent");
            asm volatile("s_waitcnt vmcnt(0)" ::: "memory");
        }
    }
    __syncthreads();
}

#ifndef REP_ATT
#define REP_ATT 1
#endif
#ifndef REP_G1
#define REP_G1 1
#endif
#ifndef EXTRA_SYNC
#define EXTRA_SYNC 0
#endif
constexpr int LDS_BYTES = 135168;
__global__ void __launch_bounds__(512, 2) fwd_kernel(Params P) {
    extern __shared__ __attribute__((aligned(16))) unsigned char lds_raw[];
    LAS unsigned char* lds = (LAS unsigned char*)lds_raw;
    cg::grid_group grid = cg::this_grid();
    const int G = gridDim.x, bid = blockIdx.x, NGW = G * 8;
    float* xout = P.out;
    int ph = 0;
    const int wave_s = __builtin_amdgcn_readfirstlane((int)(threadIdx.x >> 6));
    if (threadIdx.x < 4) ((LAS unsigned*)(lds + 131072))[threadIdx.x] = 0u;
    __syncthreads();
    XcdBarrier bar = xcd_barrier_post((unsigned*)(P.ws + WS_BAR), (volatile LAS unsigned*)(lds + 131072), wave_s);
    if (P.lo < 0) grid.sync();
#define SSQ(i) (ssq + (size_t)(i) * MTOK * 16)
#define IN(k) P.in[(k) + z_]
#define PHASE_BEGIN if (ph >= P.lo && ph < P.hi) { const int tid = wave_s * 64 + lane_now(); int z_; asm volatile("s_mov_b32 %0, 0" : "=s"(z_)); \
    const int lane = tid & 63, wave = wave_s, gw = bid * 8 + wave; unsigned char* ws = P.ws + z_; float* ssq = (float*)(ws + WS_SSQ); \
    bf16_t* xb = (bf16_t*)(ws + WS_XB); bf16_t* memb = (bf16_t*)(ws + WS_MEMB); (void)lane; (void)gw; (void)memb; (void)xb; (void)ssq;
#define PHASE_END   } if (ph >= P.lo && ph + 1 < P.hi) { xcd_barrier(bar); for (int es_ = 0; es_ < EXTRA_SYNC; ++es_) xcd_barrier(bar); } ++ph;

    PHASE_BEGIN
    {
        LAS float* scr = (LAS float*)(lds + wave * 16384);
        for (size_t i = (size_t)bid * 512 + tid; i < (size_t)2 * MTOK * 16; i += (size_t)G * 512) SSQ(SSQ_MQ)[i] = 0.f;
        LAS unsigned char* tb = lds + 131072 + 64;
        if (wave == 0 && lane == 0) {
            int nj = 0, acc = 0;
            for (int l = 0; l < 2; ++l)
                for (int j = 0; j < 2; ++j) {
                    const int f = l * 2 + j;
                    bf16_t* wgu = (bf16_t*)(ws + WS_FFN + f * SZ_FFN); bf16_t* wd = (bf16_t*)(ws + WS_FFN + f * SZ_FFN + SZ_WGU);
                    const float* gn = IN(2) + (size_t)f * DM;
                    prep_addjob(tb, nj, acc, IN(3) + (size_t)f * DM * DFF, DFF, DM, gn, 1, wgu, nullptr);
                    prep_addjob(tb, nj, acc, IN(4) + (size_t)f * DM * DFF, DFF, DM, gn, 2, wgu, nullptr);
                    prep_addjob(tb, nj, acc, IN(5) + (size_t)f * DFF * DM, DM, DFF, nullptr, 0, wd, nullptr);
                }
            prep_addjob(tb, nj, acc, IN(7), 3072, DM, IN(6), 3, (bf16_t*)(ws + WS_WQK0), (bf16_t*)(ws + WS_WV0));
            prep_addjob(tb, nj, acc, IN(8), DM, DM, nullptr, 0, (bf16_t*)(ws + WS_WOUT0), nullptr);
            prep_addjob(tb, nj, acc, IN(16), 512, DM, IN(6) + DM, 0, (bf16_t*)(ws + WS_WD1), nullptr);
            prep_addjob(tb, nj, acc, IN(19), 288, DM, IN(6) + DM, 6, (bf16_t*)(ws + WS_WD1), nullptr);
            prep_addjob(tb, nj, acc, IN(18), 1536, 512, IN(17), 0, (bf16_t*)(ws + WS_WUQ), nullptr);
            prep_addjob(tb, nj, acc, IN(21), 2048, 256, IN(20), 4, (bf16_t*)(ws + WS_WUKVK), (bf16_t*)(ws + WS_WUKVV));
            prep_addjob(tb, nj, acc, IN(24), DM, DM, nullptr, 0, (bf16_t*)(ws + WS_WO1), nullptr);
            for (int l = 0; l < 2; ++l) {
                bf16_t* base = (bf16_t*)(ws + WS_XM + l * 4 * MiB);
                prep_addjob(tb, nj, acc, IN(27) + (size_t)l * DM * 512, 512, DM, IN(25) + l * DM, 0, base, nullptr);
                prep_addjob(tb, nj, acc, IN(28) + (size_t)l * DM * 1024, 1024, DM, IN(26) + l * DM, 5, base + 512 * 1024, base + 2 * 512 * 1024);
                prep_addjob(tb, nj, acc, IN(31) + (size_t)l * 512 * DM, DM, 512, nullptr, 0, base + 3 * 512 * 1024, nullptr);
            }
        }
        __syncthreads();
        prep_all(tb, 25, scr, gw, NGW, lane);
        for (int m = gw; m < MTOK; m += 4 * NGW) {
            f32x4 v[4][4];
#pragma unroll
            for (int q = 0; q < 4; ++q)
#pragma unroll
                for (int j = 0; j < 4; ++j) v[q][j] = ((const f32x4*)(IN(0) + (size_t)(m + q * NGW) * DM))[lane + 64 * j];
#pragma unroll
            for (int q = 0; q < 4; ++q) { float sq = 0.f; unsigned long long* o8 = (unsigned long long*)(xb + (size_t)(m + q * NGW) * DM) + lane;
#pragma unroll
                for (int j = 0; j < 4; ++j) { const f32x4 w = v[q][j]; sq += (w[0] * w[0] + w[1] * w[1]) + (w[2] * w[2] + w[3] * w[3]);
                    o8[64 * j] = (unsigned long long)cvtpk(w[0], w[1]) | ((unsigned long long)cvtpk(w[2], w[3]) << 32); }
                sq = wave_sum(sq); if (lane < 16) SSQ(0)[(size_t)(m + q * NGW) * 16 + lane] = (lane == 0) ? sq : 0.f; }
        }
        for (int m = gw; m < MMEM; m += NGW) row_to_bf16(IN(1) + (size_t)m * DM, memb + (size_t)m * DM, SSQ(SSQ_MEM) + (size_t)m * 16, lane);
    }
    PHASE_END

#define RUN_GEMM(EPI_T, epi, Aptr, lda_, Bptr, ldb_, M_, N_, K_) do { pg8::Gemm g_{(const bf16_t*)(Aptr), (const bf16_t*)(Bptr), (M_), (N_), (K_), (lda_), (ldb_)}; \
        pg8::StaticOrder S_; S_.init((M_), (N_), G, bid); pg8::gemm_phase<EPI_T>(lds, g_, S_, epi, wave_s); } while (0)
#define SNAKE(r_) ((r_) * G + (((r_) & 1) ? (G - 1 - bid) : bid))

    int nssq = 0;
    const float* xcur = P.in[0];
    { constexpr int layer = 0, half = 0;
            if constexpr (half == 1) {
                if constexpr (layer == 0) {
                    PHASE_BEGIN
                    { pg8::EpiQK0 e{(bf16_t*)(ws + WS_QK0), SSQ(nssq), IN(9), IN(10), 0.125f * LOG2E};
                      RUN_GEMM(pg8::EpiQK0, e, xb, DM, ws + WS_WQK0, DM, MTOK, 2048, DM);
                      pg8::EpiOutT et{(bf16_t*)(ws + WS_VT0), MTOK, SSQ(nssq), 1.0f / DM};
                      RUN_GEMM(pg8::EpiOutT, et, ws + WS_WV0, DM, xb, DM, 1024, MTOK, DM); }
                    PHASE_END
                    PHASE_BEGIN
                    { const bf16_t* QK = (const bf16_t*)(ws + WS_QK0); const bf16_t* VT = (const bf16_t*)(ws + WS_VT0);
                      float la = IN(11)[lane] * IN(12)[lane], lb2 = IN(13)[lane] * IN(14)[lane];
                      la = wave_sum(la); lb2 = wave_sum(lb2);
                      const float lam = expf(la) - expf(lb2) + 0.2f;
                      for (int rep = 0; rep < REP_ATT; ++rep) for (int r = 0;; ++r) { const int u = SNAKE(r); if (u >= 512) break;
                          const int qb = 15 - (u >> 5), bh = u & 31, b = bh >> 2, h = bh & 3;
                          attn_unit<64, 128, 0, 0, true>(lds, QK + (size_t)b * SEQ * 2048 + h * 64, 2048, QK + (size_t)b * SEQ * 2048 + 512 + h * 64, 2048,
                                                VT + (size_t)(h * 128) * MTOK + (size_t)b * SEQ, MTOK, (bf16_t*)(ws + WS_MIX0) + (size_t)b * SEQ * 1024 + h * 128, 1024,
                                                qb * 256, qb * 4 + 4, 0.125f * LOG2E, nullptr, IN(15), lam, 0.8f, wave_s); }
                      for (int rep = 0; rep < REP_ATT; ++rep) for (int r = 0;; ++r) { const int u = SNAKE(r); if (u >= 1024) break;
                          const int qb = 15 - (u >> 6), bh = u & 63, b = bh >> 3, h = bh & 7;
                          attn_unit<64, 64, 1, 0, false>(lds, QK + (size_t)b * SEQ * 2048 + 1024 + h * 64, 2048, QK + (size_t)b * SEQ * 2048 + 1536 + h * 64, 2048,
                                               VT + (size_t)(512 + h * 64) * MTOK + (size_t)b * SEQ, MTOK, (bf16_t*)(ws + WS_MIX0) + (size_t)b * SEQ * 1024 + 512 + h * 64, 1024,
                                               qb * 256, qb * 4 + 4, 0.125f * LOG2E, nullptr, nullptr, 0.f, 0.f, wave_s); } }
                    PHASE_END
                    PHASE_BEGIN
                    { pg8::EpiResidB<1> e{nullptr, nullptr, xb, SSQ(nssq + 1), 1.0f};
                      RUN_GEMM(pg8::EpiResidB<1>, e, ws + WS_MIX0, DM, ws + WS_WOUT0, DM, MTOK, DM, DM); }
                    PHASE_END
                    ++nssq;
                } else {
                    PHASE_BEGIN
                    { pg8::EpiOut e{(bf16_t*)(ws + WS_T1), 1024, SSQ(nssq), 1.0f / DM, 0, 0, {SSQ(SSQ_MQ), SSQ(SSQ_MQ), SSQ(SSQ_MKV), nullptr}};
                      RUN_GEMM(pg8::EpiOut, e, xb, DM, ws + WS_WD1, DM, MTOK, 1024, DM); }
                    PHASE_END
                    PHASE_BEGIN
                    { const bf16_t* T1 = (const bf16_t*)(ws + WS_T1);
                      pg8::EpiOut eq{(bf16_t*)(ws + WS_Q1), 1536, SSQ(SSQ_MQ), 1.0f / 512.0f, 0, 0, {nullptr, nullptr, nullptr, nullptr}};
                      RUN_GEMM(pg8::EpiOut, eq, T1, 1024, ws + WS_WUQ, 512, MTOK, 1536, 512);
                      pg8::EpiK1 ek{(bf16_t*)(ws + WS_K1), T1, SSQ(SSQ_MKV), IN(23)};
                      RUN_GEMM(pg8::EpiK1, ek, T1 + 512, 1024, ws + WS_WUKVK, 256, MTOK, 1024, 256);
                      pg8::EpiOutT ev{(bf16_t*)(ws + WS_VT1), MTOK, SSQ(SSQ_MKV), 1.0f / 256.0f};
                      RUN_GEMM(pg8::EpiOutT, ev, ws + WS_WUKVV, 256, T1 + 512, 1024, 1024, MTOK, 256); }
                    PHASE_END
                    PHASE_BEGIN
                    { const bf16_t* Q1 = (const bf16_t*)(ws + WS_Q1); const bf16_t* K1 = (const bf16_t*)(ws + WS_K1); const bf16_t* VT = (const bf16_t*)(ws + WS_VT1);
                      for (int rep = 0; rep < REP_ATT; ++rep) for (int r = 0;; ++r) { const int u = SNAKE(r); if (u >= 2048) break;
                          const int qb = 15 - (u >> 7), bh = u & 127, b = bh >> 4, h = bh & 15;
                          attn_unit<96, 64, 0, 3, false>(lds, Q1 + (size_t)b * SEQ * 1536 + h * 96, 1536, K1 + (size_t)b * SEQ * 1536 + h * 96, 1536,
                                               VT + (size_t)(h * 64) * MTOK + (size_t)b * SEQ, MTOK, (bf16_t*)(ws + WS_O1) + (size_t)b * SEQ * 1024 + h * 64, 1024,
                                               qb * 256, qb * 4 + 4, 0.10206207261596575f * LOG2E, IN(22), nullptr, 0.f, 0.f, wave_s); } }
                    PHASE_END
                    PHASE_BEGIN
                    { pg8::EpiResidB<1> e{nullptr, nullptr, xb, SSQ(nssq + 1), 1.0f};
                      RUN_GEMM(pg8::EpiResidB<1>, e, ws + WS_O1, DM, ws + WS_WO1, DM, MTOK, DM, DM); }
                    PHASE_END
                    ++nssq;
                }
                {
#define xmw ((const bf16_t*)(ws + WS_XM + layer * 4 * MiB))
                    PHASE_BEGIN
                    { pg8::EpiOut e{(bf16_t*)(ws + WS_XQ), 512, SSQ(nssq), 1.0f / DM, 0, 0, {nullptr, nullptr, nullptr, nullptr}};
                      RUN_GEMM(pg8::EpiOut, e, xb, DM, xmw, DM, MTOK, 512, DM); }
                    PHASE_END
                    PHASE_BEGIN
                    { const bf16_t* XQ = (const bf16_t*)(ws + WS_XQ); const bf16_t* KM = (const bf16_t*)(ws + WS_KMEM) + (size_t)layer * MMEM * 512;
                      const bf16_t* VM = (const bf16_t*)(ws + WS_VTMEM) + (size_t)layer * 512 * MMEM;
                      for (int rep = 0; rep < REP_ATT; ++rep) for (int r = 0;; ++r) { const int u = r * G + bid; if (u >= 512) break;
                          const int qb = u >> 5, bh = u & 31, b = bh >> 2, h = bh & 3;
                          attn_unit<128, 128, 2, 1, false>(lds, XQ + (size_t)b * SEQ * 512 + h * 128, 512, KM + (size_t)b * MEMLEN * 512 + h * 128, 512,
                                                 VM + (size_t)(h * 128) * MMEM + (size_t)b * MEMLEN, MMEM, (bf16_t*)(ws + WS_XO) + (size_t)b * SEQ * 512 + h * 128, 512,
                                                 qb * 256, 4, 0.08838834764831845f * LOG2E, IN(29) + layer * 128, nullptr, 0.f, 0.f, wave_s); } }
                    PHASE_END
                    PHASE_BEGIN
                    { pg8::EpiResidB<1> e{nullptr, nullptr, xb, SSQ(nssq + 1), 1.0f};
                      RUN_GEMM(pg8::EpiResidB<1>, e, ws + WS_XO, 512, xmw + 3 * 512 * 1024, 512, MTOK, DM, 512); }
                    PHASE_END
                    ++nssq;
#undef xmw
                }
            }
            const int f = layer * 2 + half;
            PHASE_BEGIN
            { pg8::EpiSwiGLU e{(bf16_t*)(ws + WS_H), SSQ(nssq)};
              for (int rep = 0; rep < REP_G1; ++rep) RUN_GEMM(pg8::EpiSwiGLU, e, xb, DM, ws + WS_FFN + f * SZ_FFN, DM, MTOK, 2 * DFF, DM);
              if constexpr (layer == 0 && half == 0) {
                  for (int l = 0; l < 2; ++l) {
                      const bf16_t* xmw = (const bf16_t*)(ws + WS_XM + l * 4 * MiB);
                      pg8::EpiOut ek{(bf16_t*)(ws + WS_KMEM) + (size_t)l * MMEM * 512, 512, SSQ(SSQ_MEM), 1.0f / DM, 0, 0, {nullptr, nullptr, nullptr, nullptr}};
                      RUN_GEMM(pg8::EpiOut, ek, memb, DM, xmw + 512 * 1024, DM, MMEM, 512, DM);
                      pg8::EpiOutT ev{(bf16_t*)(ws + WS_VTMEM) + (size_t)l * 512 * MMEM, MMEM, SSQ(SSQ_MEM), 1.0f / DM};
                      RUN_GEMM(pg8::EpiOutT, ev, xmw + 2 * 512 * 1024, DM, memb, DM, 512, MMEM, DM);
                  }
              } }
            PHASE_END
            PHASE_BEGIN
            { constexpr int RMV = (layer == 0 && half == 0) ? 0 : ((layer == 1 && half == 1) ? 2 : 1);
              pg8::EpiResidB<RMV> e{IN(0), xout, xb, SSQ(nssq + 1), 0.5f};
              RUN_GEMM(pg8::EpiResidB<RMV>, e, ws + WS_H, DFF, ws + WS_FFN + f * SZ_FFN + SZ_WGU, DFF, MTOK, DM, DFF);
              if constexpr (layer == 0 && half == 0) {
                  for (int l = 0; l < 2; ++l) pp_norm128((bf16_t*)(ws + WS_KMEM) + (size_t)l * MMEM * 512, MMEM * 4, IN(30) + l * 128, gw, NGW, lane);
              } }
            PHASE_END
            ++nssq; xcur = xout;
    }
    { constexpr int layer = 0, half = 1;
            if constexpr (half == 1) {
                if constexpr (layer == 0) {
                    PHASE_BEGIN
                    { pg8::EpiQK0 e{(bf16_t*)(ws + WS_QK0), SSQ(nssq), IN(9), IN(10), 0.125f * LOG2E};
                      RUN_GEMM(pg8::EpiQK0, e, xb, DM, ws + WS_WQK0, DM, MTOK, 2048, DM);
                      pg8::EpiOutT et{(bf16_t*)(ws + WS_VT0), MTOK, SSQ(nssq), 1.0f / DM};
                      RUN_GEMM(pg8::EpiOutT, et, ws + WS_WV0, DM, xb, DM, 1024, MTOK, DM); }
                    PHASE_END
                    PHASE_BEGIN
                    { const bf16_t* QK = (const bf16_t*)(ws + WS_QK0); const bf16_t* VT = (const bf16_t*)(ws + WS_VT0);
                      float la = IN(11)[lane] * IN(12)[lane], lb2 = IN(13)[lane] * IN(14)[lane];
                      la = wave_sum(la); lb2 = wave_sum(lb2);
                      const float lam = expf(la) - expf(lb2) + 0.2f;
                      for (int rep = 0; rep < REP_ATT; ++rep) for (int r = 0;; ++r) { const int u = SNAKE(r); if (u >= 512) break;
                          const int qb = 15 - (u >> 5), bh = u & 31, b = bh >> 2, h = bh & 3;
                          attn_unit<64, 128, 0, 0, true>(lds, QK + (size_t)b * SEQ * 2048 + h * 64, 2048, QK + (size_t)b * SEQ * 2048 + 512 + h * 64, 2048,
                                                VT + (size_t)(h * 128) * MTOK + (size_t)b * SEQ, MTOK, (bf16_t*)(ws + WS_MIX0) + (size_t)b * SEQ * 1024 + h * 128, 1024,
                                                qb * 256, qb * 4 + 4, 0.125f * LOG2E, nullptr, IN(15), lam, 0.8f, wave_s); }
                      for (int rep = 0; rep < REP_ATT; ++rep) for (int r = 0;; ++r) { const int u = SNAKE(r); if (u >= 1024) break;
                          const int qb = 15 - (u >> 6), bh = u & 63, b = bh >> 3, h = bh & 7;
                          attn_unit<64, 64, 1, 0, false>(lds, QK + (size_t)b * SEQ * 2048 + 1024 + h * 64, 2048, QK + (size_t)b * SEQ * 2048 + 1536 + h * 64, 2048,
                                               VT + (size_t)(512 + h * 64) * MTOK + (size_t)b * SEQ, MTOK, (bf16_t*)(ws + WS_MIX0) + (size_t)b * SEQ * 1024 + 512 + h * 64, 1024,
                                               qb * 256, qb * 4 + 4, 0.125f * LOG2E, nullptr, nullptr, 0.f, 0.f, wave_s); } }
                    PHASE_END
                    PHASE_BEGIN
                    { pg8::EpiResidB<1> e{nullptr, nullptr, xb, SSQ(nssq + 1), 1.0f};
                      RUN_GEMM(pg8::EpiResidB<1>, e, ws + WS_MIX0, DM, ws + WS_WOUT0, DM, MTOK, DM, DM); }
                    PHASE_END
                    ++nssq;
                } else {
                    PHASE_BEGIN
                    { pg8::EpiOut e{(bf16_t*)(ws + WS_T1), 1024, SSQ(nssq), 1.0f / DM, 0, 0, {SSQ(SSQ_MQ), SSQ(SSQ_MQ), SSQ(SSQ_MKV), nullptr}};
                      RUN_GEMM(pg8::EpiOut, e, xb, DM, ws + WS_WD1, DM, MTOK, 1024, DM); }
                    PHASE_END
                    PHASE_BEGIN
                    { const bf16_t* T1 = (const bf16_t*)(ws + WS_T1);
                      pg8::EpiOut eq{(bf16_t*)(ws + WS_Q1), 1536, SSQ(SSQ_MQ), 1.0f / 512.0f, 0, 0, {nullptr, nullptr, nullptr, nullptr}};
                      RUN_GEMM(pg8::EpiOut, eq, T1, 1024, ws + WS_WUQ, 512, MTOK, 1536, 512);
                      pg8::EpiK1 ek{(bf16_t*)(ws + WS_K1), T1, SSQ(SSQ_MKV), IN(23)};
                      RUN_GEMM(pg8::EpiK1, ek, T1 + 512, 1024, ws + WS_WUKVK, 256, MTOK, 1024, 256);
                      pg8::EpiOutT ev{(bf16_t*)(ws + WS_VT1), MTOK, SSQ(SSQ_MKV), 1.0f / 256.0f};
                      RUN_GEMM(pg8::EpiOutT, ev, ws + WS_WUKVV, 256, T1 + 512, 1024, 1024, MTOK, 256); }
                    PHASE_END
                    PHASE_BEGIN
                    { const bf16_t* Q1 = (const bf16_t*)(ws + WS_Q1); const bf16_t* K1 = (const bf16_t*)(ws + WS_K1); const bf16_t* VT = (const bf16_t*)(ws + WS_VT1);
                      for (int rep = 0; rep < REP_ATT; ++rep) for (int r = 0;; ++r) { const int u = SNAKE(r); if (u >= 2048) break;
                          const int qb = 15 - (u >> 7), bh = u & 127, b = bh >> 4, h = bh & 15;
                          attn_unit<96, 64, 0, 3, false>(lds, Q1 + (size_t)b * SEQ * 1536 + h * 96, 1536, K1 + (size_t)b * SEQ * 1536 + h * 96, 1536,
                                               VT + (size_t)(h * 64) * MTOK + (size_t)b * SEQ, MTOK, (bf16_t*)(ws + WS_O1) + (size_t)b * SEQ * 1024 + h * 64, 1024,
                                               qb * 256, qb * 4 + 4, 0.10206207261596575f * LOG2E, IN(22), nullptr, 0.f, 0.f, wave_s); } }
                    PHASE_END
                    PHASE_BEGIN
                    { pg8::EpiResidB<1> e{nullptr, nullptr, xb, SSQ(nssq + 1), 1.0f};
                      RUN_GEMM(pg8::EpiResidB<1>, e, ws + WS_O1, DM, ws + WS_WO1, DM, MTOK, DM, DM); }
                    PHASE_END
                    ++nssq;
                }
                {
#define xmw ((const bf16_t*)(ws + WS_XM + layer * 4 * MiB))
                    PHASE_BEGIN
                    { pg8::EpiOut e{(bf16_t*)(ws + WS_XQ), 512, SSQ(nssq), 1.0f / DM, 0, 0, {nullptr, nullptr, nullptr, nullptr}};
                      RUN_GEMM(pg8::EpiOut, e, xb, DM, xmw, DM, MTOK, 512, DM); }
                    PHASE_END
                    PHASE_BEGIN
                    { const bf16_t* XQ = (const bf16_t*)(ws + WS_XQ); const bf16_t* KM = (const bf16_t*)(ws + WS_KMEM) + (size_t)layer * MMEM * 512;
                      const bf16_t* VM = (const bf16_t*)(ws + WS_VTMEM) + (size_t)layer * 512 * MMEM;
                      for (int rep = 0; rep < REP_ATT; ++rep) for (int r = 0;; ++r) { const int u = r * G + bid; if (u >= 512) break;
                          const int qb = u >> 5, bh = u & 31, b = bh >> 2, h = bh & 3;
                          attn_unit<128, 128, 2, 1, false>(lds, XQ + (size_t)b * SEQ * 512 + h * 128, 512, KM + (size_t)b * MEMLEN * 512 + h * 128, 512,
                                                 VM + (size_t)(h * 128) * MMEM + (size_t)b * MEMLEN, MMEM, (bf16_t*)(ws + WS_XO) + (size_t)b * SEQ * 512 + h * 128, 512,
                                                 qb * 256, 4, 0.08838834764831845f * LOG2E, IN(29) + layer * 128, nullptr, 0.f, 0.f, wave_s); } }
                    PHASE_END
                    PHASE_BEGIN
                    { pg8::EpiResidB<1> e{nullptr, nullptr, xb, SSQ(nssq + 1), 1.0f};
                      RUN_GEMM(pg8::EpiResidB<1>, e, ws + WS_XO, 512, xmw + 3 * 512 * 1024, 512, MTOK, DM, 512); }
                    PHASE_END
                    ++nssq;
#undef xmw
                }
            }
            const int f = layer * 2 + half;
            PHASE_BEGIN
            { pg8::EpiSwiGLU e{(bf16_t*)(ws + WS_H), SSQ(nssq)};
              for (int rep = 0; rep < REP_G1; ++rep) RUN_GEMM(pg8::EpiSwiGLU, e, xb, DM, ws + WS_FFN + f * SZ_FFN, DM, MTOK, 2 * DFF, DM);
              if constexpr (layer == 0 && half == 0) {
                  for (int l = 0; l < 2; ++l) {
                      const bf16_t* xmw = (const bf16_t*)(ws + WS_XM + l * 4 * MiB);
                      pg8::EpiOut ek{(bf16_t*)(ws + WS_KMEM) + (size_t)l * MMEM * 512, 512, SSQ(SSQ_MEM), 1.0f / DM, 0, 0, {nullptr, nullptr, nullptr, nullptr}};
                      RUN_GEMM(pg8::EpiOut, ek, memb, DM, xmw + 512 * 1024, DM, MMEM, 512, DM);
                      pg8::EpiOutT ev{(bf16_t*)(ws + WS_VTMEM) + (size_t)l * 512 * MMEM, MMEM, SSQ(SSQ_MEM), 1.0f / DM};
                      RUN_GEMM(pg8::EpiOutT, ev, xmw + 2 * 512 * 1024, DM, memb, DM, 512, MMEM, DM);
                  }
              } }
            PHASE_END
            PHASE_BEGIN
            { constexpr int RMV = (layer == 0 && half == 0) ? 0 : ((layer == 1 && half == 1) ? 2 : 1);
              pg8::EpiResidB<RMV> e{IN(0), xout, xb, SSQ(nssq + 1), 0.5f};
              RUN_GEMM(pg8::EpiResidB<RMV>, e, ws + WS_H, DFF, ws + WS_FFN + f * SZ_FFN + SZ_WGU, DFF, MTOK, DM, DFF);
              if constexpr (layer == 0 && half == 0) {
                  for (int l = 0; l < 2; ++l) pp_norm128((bf16_t*)(ws + WS_KMEM) + (size_t)l * MMEM * 512, MMEM * 4, IN(30) + l * 128, gw, NGW, lane);
              } }
            PHASE_END
            ++nssq; xcur = xout;
    }
    { constexpr int layer = 1, half = 0;
            if constexpr (half == 1) {
                if constexpr (layer == 0) {
                    PHASE_BEGIN
                    { pg8::EpiQK0 e{(bf16_t*)(ws + WS_QK0), SSQ(nssq), IN(9), IN(10), 0.125f * LOG2E};
                      RUN_GEMM(pg8::EpiQK0, e, xb, DM, ws + WS_WQK0, DM, MTOK, 2048, DM);
                      pg8::EpiOutT et{(bf16_t*)(ws + WS_VT0), MTOK, SSQ(nssq), 1.0f / DM};
                      RUN_GEMM(pg8::EpiOutT, et, ws + WS_WV0, DM, xb, DM, 1024, MTOK, DM); }
                    PHASE_END
                    PHASE_BEGIN
                    { const bf16_t* QK = (const bf16_t*)(ws + WS_QK0); const bf16_t* VT = (const bf16_t*)(ws + WS_VT0);
                      float la = IN(11)[lane] * IN(12)[lane], lb2 = IN(13)[lane] * IN(14)[lane];
                      la = wave_sum(la); lb2 = wave_sum(lb2);
                      const float lam = expf(la) - expf(lb2) + 0.2f;
                      for (int rep = 0; rep < REP_ATT; ++rep) for (int r = 0;; ++r) { const int u = SNAKE(r); if (u >= 512) break;
                          const int qb = 15 - (u >> 5), bh = u & 31, b = bh >> 2, h = bh & 3;
                          attn_unit<64, 128, 0, 0, true>(lds, QK + (size_t)b * SEQ * 2048 + h * 64, 2048, QK + (size_t)b * SEQ * 2048 + 512 + h * 64, 2048,
                                                VT + (size_t)(h * 128) * MTOK + (size_t)b * SEQ, MTOK, (bf16_t*)(ws + WS_MIX0) + (size_t)b * SEQ * 1024 + h * 128, 1024,
                                                qb * 256, qb * 4 + 4, 0.125f * LOG2E, nullptr, IN(15), lam, 0.8f, wave_s); }
                      for (int rep = 0; rep < REP_ATT; ++rep) for (int r = 0;; ++r) { const int u = SNAKE(r); if (u >= 1024) break;
                          const int qb = 15 - (u >> 6), bh = u & 63, b = bh >> 3, h = bh & 7;
                          attn_unit<64, 64, 1, 0, false>(lds, QK + (size_t)b * SEQ * 2048 + 1024 + h * 64, 2048, QK + (size_t)b * SEQ * 2048 + 1536 + h * 64, 2048,
                                               VT + (size_t)(512 + h * 64) * MTOK + (size_t)b * SEQ, MTOK, (bf16_t*)(ws + WS_MIX0) + (size_t)b * SEQ * 1024 + 512 + h * 64, 1024,
                                               qb * 256, qb * 4 + 4, 0.125f * LOG2E, nullptr, nullptr, 0.f, 0.f, wave_s); } }
                    PHASE_END
                    PHASE_BEGIN
                    { pg8::EpiResidB<1> e{nullptr, nullptr, xb, SSQ(nssq + 1), 1.0f};
                      RUN_GEMM(pg8::EpiResidB<1>, e, ws + WS_MIX0, DM, ws + WS_WOUT0, DM, MTOK, DM, DM); }
                    PHASE_END
                    ++nssq;
                } else {
                    PHASE_BEGIN
                    { pg8::EpiOut e{(bf16_t*)(ws + WS_T1), 1024, SSQ(nssq), 1.0f / DM, 0, 0, {SSQ(SSQ_MQ), SSQ(SSQ_MQ), SSQ(SSQ_MKV), nullptr}};
                      RUN_GEMM(pg8::EpiOut, e, xb, DM, ws + WS_WD1, DM, MTOK, 1024, DM); }
                    PHASE_END
                    PHASE_BEGIN
                    { const bf16_t* T1 = (const bf16_t*)(ws + WS_T1);
                      pg8::EpiOut eq{(bf16_t*)(ws + WS_Q1), 1536, SSQ(SSQ_MQ), 1.0f / 512.0f, 0, 0, {nullptr, nullptr, nullptr, nullptr}};
                      RUN_GEMM(pg8::EpiOut, eq, T1, 1024, ws + WS_WUQ, 512, MTOK, 1536, 512);
                      pg8::EpiK1 ek{(bf16_t*)(ws + WS_K1), T1, SSQ(SSQ_MKV), IN(23)};
                      RUN_GEMM(pg8::EpiK1, ek, T1 + 512, 1024, ws + WS_WUKVK, 256, MTOK, 1024, 256);
                      pg8::EpiOutT ev{(bf16_t*)(ws + WS_VT1), MTOK, SSQ(SSQ_MKV), 1.0f / 256.0f};
                      RUN_GEMM(pg8::EpiOutT, ev, ws + WS_WUKVV, 256, T1 + 512, 1024, 1024, MTOK, 256); }
                    PHASE_END
                    PHASE_BEGIN
                    { const bf16_t* Q1 = (const bf16_t*)(ws + WS_Q1); const bf16_t* K1 = (const bf16_t*)(ws + WS_K1); const bf16_t* VT = (const bf16_t*)(ws + WS_VT1);
                      for (int rep = 0; rep < REP_ATT; ++rep) for (int r = 0;; ++r) { const int u = SNAKE(r); if (u >= 2048) break;
                          const int qb = 15 - (u >> 7), bh = u & 127, b = bh >> 4, h = bh & 15;
                          attn_unit<96, 64, 0, 3, false>(lds, Q1 + (size_t)b * SEQ * 1536 + h * 96, 1536, K1 + (size_t)b * SEQ * 1536 + h * 96, 1536,
                                               VT + (size_t)(h * 64) * MTOK + (size_t)b * SEQ, MTOK, (bf16_t*)(ws + WS_O1) + (size_t)b * SEQ * 1024 + h * 64, 1024,
                                               qb * 256, qb * 4 + 4, 0.10206207261596575f * LOG2E, IN(22), nullptr, 0.f, 0.f, wave_s); } }
                    PHASE_END
                    PHASE_BEGIN
                    { pg8::EpiResidB<1> e{nullptr, nullptr, xb, SSQ(nssq + 1), 1.0f};
                      RUN_GEMM(pg8::EpiResidB<1>, e, ws + WS_O1, DM, ws + WS_WO1, DM, MTOK, DM, DM); }
                    PHASE_END
                    ++nssq;
                }
                {
#define xmw ((const bf16_t*)(ws + WS_XM + layer * 4 * MiB))
                    PHASE_BEGIN
                    { pg8::EpiOut e{(bf16_t*)(ws + WS_XQ), 512, SSQ(nssq), 1.0f / DM, 0, 0, {nullptr, nullptr, nullptr, nullptr}};
                      RUN_GEMM(pg8::EpiOut, e, xb, DM, xmw, DM, MTOK, 512, DM); }
                    PHASE_END
                    PHASE_BEGIN
                    { const bf16_t* XQ = (const bf16_t*)(ws + WS_XQ); const bf16_t* KM = (const bf16_t*)(ws + WS_KMEM) + (size_t)layer * MMEM * 512;
                      const bf16_t* VM = (const bf16_t*)(ws + WS_VTMEM) + (size_t)layer * 512 * MMEM;
                      for (int rep = 0; rep < REP_ATT; ++rep) for (int r = 0;; ++r) { const int u = r * G + bid; if (u >= 512) break;
                          const int qb = u >> 5, bh = u & 31, b = bh >> 2, h = bh & 3;
                          attn_unit<128, 128, 2, 1, false>(lds, XQ + (size_t)b * SEQ * 512 + h * 128, 512, KM + (size_t)b * MEMLEN * 512 + h * 128, 512,
                                                 VM + (size_t)(h * 128) * MMEM + (size_t)b * MEMLEN, MMEM, (bf16_t*)(ws + WS_XO) + (size_t)b * SEQ * 512 + h * 128, 512,
                                                 qb * 256, 4, 0.08838834764831845f * LOG2E, IN(29) + layer * 128, nullptr, 0.f, 0.f, wave_s); } }
                    PHASE_END
                    PHASE_BEGIN
                    { pg8::EpiResidB<1> e{nullptr, nullptr, xb, SSQ(nssq + 1), 1.0f};
                      RUN_GEMM(pg8::EpiResidB<1>, e, ws + WS_XO, 512, xmw + 3 * 512 * 1024, 512, MTOK, DM, 512); }
                    PHASE_END
                    ++nssq;
#undef xmw
                }
            }
            const int f = layer * 2 + half;
            PHASE_BEGIN
            { pg8::EpiSwiGLU e{(bf16_t*)(ws + WS_H), SSQ(nssq)};
              for (int rep = 0; rep < REP_G1; ++rep) RUN_GEMM(pg8::EpiSwiGLU, e, xb, DM, ws + WS_FFN + f * SZ_FFN, DM, MTOK, 2 * DFF, DM);
              if constexpr (layer == 0 && half == 0) {
                  for (int l = 0; l < 2; ++l) {
                      const bf16_t* xmw = (const bf16_t*)(ws + WS_XM + l * 4 * MiB);
                      pg8::EpiOut ek{(bf16_t*)(ws + WS_KMEM) + (size_t)l * MMEM * 512, 512, SSQ(SSQ_MEM), 1.0f / DM, 0, 0, {nullptr, nullptr, nullptr, nullptr}};
                      RUN_GEMM(pg8::EpiOut, ek, memb, DM, xmw + 512 * 1024, DM, MMEM, 512, DM);
                      pg8::EpiOutT ev{(bf16_t*)(ws + WS_VTMEM) + (size_t)l * 512 * MMEM, MMEM, SSQ(SSQ_MEM), 1.0f / DM};
                      RUN_GEMM(pg8::EpiOutT, ev, xmw + 2 * 512 * 1024, DM, memb, DM, 512, MMEM, DM);
                  }
              } }
            PHASE_END
            PHASE_BEGIN
            { constexpr int RMV = (layer == 0 && half == 0) ? 0 : ((layer == 1 && half == 1) ? 2 : 1);
              pg8::EpiResidB<RMV> e{IN(0), xout, xb, SSQ(nssq + 1), 0.5f};
              RUN_GEMM(pg8::EpiResidB<RMV>, e, ws + WS_H, DFF, ws + WS_FFN + f * SZ_FFN + SZ_WGU, DFF, MTOK, DM, DFF);
              if constexpr (layer == 0 && half == 0) {
                  for (int l = 0; l < 2; ++l) pp_norm128((bf16_t*)(ws + WS_KMEM) + (size_t)l * MMEM * 512, MMEM * 4, IN(30) + l * 128, gw, NGW, lane);
              } }
            PHASE_END
            ++nssq; xcur = xout;
    }
    { constexpr int layer = 1, half = 1;
            if constexpr (half == 1) {
                if constexpr (layer == 0) {
                    PHASE_BEGIN
                    { pg8::EpiQK0 e{(bf16_t*)(ws + WS_QK0), SSQ(nssq), IN(9), IN(10), 0.125f * LOG2E};
                      RUN_GEMM(pg8::EpiQK0, e, xb, DM, ws + WS_WQK0, DM, MTOK, 2048, DM);
                      pg8::EpiOutT et{(bf16_t*)(ws + WS_VT0), MTOK, SSQ(nssq), 1.0f / DM};
                      RUN_GEMM(pg8::EpiOutT, et, ws + WS_WV0, DM, xb, DM, 1024, MTOK, DM); }
                    PHASE_END
                    PHASE_BEGIN
                    { const bf16_t* QK = (const bf16_t*)(ws + WS_QK0); const bf16_t* VT = (const bf16_t*)(ws + WS_VT0);
                      float la = IN(11)[lane] * IN(12)[lane], lb2 = IN(13)[lane] * IN(14)[lane];
                      la = wave_sum(la); lb2 = wave_sum(lb2);
                      const float lam = expf(la) - expf(lb2) + 0.2f;
                      for (int rep = 0; rep < REP_ATT; ++rep) for (int r = 0;; ++r) { const int u = SNAKE(r); if (u >= 512) break;
                          const int qb = 15 - (u >> 5), bh = u & 31, b = bh >> 2, h = bh & 3;
                          attn_unit<64, 128, 0, 0, true>(lds, QK + (size_t)b * SEQ * 2048 + h * 64, 2048, QK + (size_t)b * SEQ * 2048 + 512 + h * 64, 2048,
                                                VT + (size_t)(h * 128) * MTOK + (size_t)b * SEQ, MTOK, (bf16_t*)(ws + WS_MIX0) + (size_t)b * SEQ * 1024 + h * 128, 1024,
                                                qb * 256, qb * 4 + 4, 0.125f * LOG2E, nullptr, IN(15), lam, 0.8f, wave_s); }
                      for (int rep = 0; rep < REP_ATT; ++rep) for (int r = 0;; ++r) { const int u = SNAKE(r); if (u >= 1024) break;
                          const int qb = 15 - (u >> 6), bh = u & 63, b = bh >> 3, h = bh & 7;
                          attn_unit<64, 64, 1, 0, false>(lds, QK + (size_t)b * SEQ * 2048 + 1024 + h * 64, 2048, QK + (size_t)b * SEQ * 2048 + 1536 + h * 64, 2048,
                                               VT + (size_t)(512 + h * 64) * MTOK + (size_t)b * SEQ, MTOK, (bf16_t*)(ws + WS_MIX0) + (size_t)b * SEQ * 1024 + 512 + h * 64, 1024,
                                               qb * 256, qb * 4 + 4, 0.125f * LOG2E, nullptr, nullptr, 0.f, 0.f, wave_s); } }
                    PHASE_END
                    PHASE_BEGIN
                    { pg8::EpiResidB<1> e{nullptr, nullptr, xb, SSQ(nssq + 1), 1.0f};
                      RUN_GEMM(pg8::EpiResidB<1>, e, ws + WS_MIX0, DM, ws + WS_WOUT0, DM, MTOK, DM, DM); }
                    PHASE_END
                    ++nssq;
                } else {
                    PHASE_BEGIN
                    { pg8::EpiOut e{(bf16_t*)(ws + WS_T1), 1024, SSQ(nssq), 1.0f / DM, 0, 0, {SSQ(SSQ_MQ), SSQ(SSQ_MQ), SSQ(SSQ_MKV), nullptr}};
                      RUN_GEMM(pg8::EpiOut, e, xb, DM, ws + WS_WD1, DM, MTOK, 1024, DM); }
                    PHASE_END
                    PHASE_BEGIN
                    { const bf16_t* T1 = (const bf16_t*)(ws + WS_T1);
                      pg8::EpiOut eq{(bf16_t*)(ws + WS_Q1), 1536, SSQ(SSQ_MQ), 1.0f / 512.0f, 0, 0, {nullptr, nullptr, nullptr, nullptr}};
                      RUN_GEMM(pg8::EpiOut, eq, T1, 1024, ws + WS_WUQ, 512, MTOK, 1536, 512);
                      pg8::EpiK1 ek{(bf16_t*)(ws + WS_K1), T1, SSQ(SSQ_MKV), IN(23)};
                      RUN_GEMM(pg8::EpiK1, ek, T1 + 512, 1024, ws + WS_WUKVK, 256, MTOK, 1024, 256);
                      pg8::EpiOutT ev{(bf16_t*)(ws + WS_VT1), MTOK, SSQ(SSQ_MKV), 1.0f / 256.0f};
                      RUN_GEMM(pg8::EpiOutT, ev, ws + WS_WUKVV, 256, T1 + 512, 1024, 1024, MTOK, 256); }
                    PHASE_END
                    PHASE_BEGIN
                    { const bf16_t* Q1 = (const bf16_t*)(ws + WS_Q1); const bf16_t* K1 = (const bf16_t*)(ws + WS_K1); const bf16_t* VT = (const bf16_t*)(ws + WS_VT1);
                      for (int rep = 0; rep < REP_ATT; ++rep) for (int r = 0;; ++r) { const int u = SNAKE(r); if (u >= 2048) break;
                          const int qb = 15 - (u >> 7), bh = u & 127, b = bh >> 4, h = bh & 15;
                          attn_unit<96, 64, 0, 3, false>(lds, Q1 + (size_t)b * SEQ * 1536 + h * 96, 1536, K1 + (size_t)b * SEQ * 1536 + h * 96, 1536,
                                               VT + (size_t)(h * 64) * MTOK + (size_t)b * SEQ, MTOK, (bf16_t*)(ws + WS_O1) + (size_t)b * SEQ * 1024 + h * 64, 1024,
                                               qb * 256, qb * 4 + 4, 0.10206207261596575f * LOG2E, IN(22), nullptr, 0.f, 0.f, wave_s); } }
                    PHASE_END
                    PHASE_BEGIN
                    { pg8::EpiResidB<1> e{nullptr, nullptr, xb, SSQ(nssq + 1), 1.0f};
                      RUN_GEMM(pg8::EpiResidB<1>, e, ws + WS_O1, DM, ws + WS_WO1, DM, MTOK, DM, DM); }
                    PHASE_END
                    ++nssq;
                }
                {
#define xmw ((const bf16_t*)(ws + WS_XM + layer * 4 * MiB))
                    PHASE_BEGIN
                    { pg8::EpiOut e{(bf16_t*)(ws + WS_XQ), 512, SSQ(nssq), 1.0f / DM, 0, 0, {nullptr, nullptr, nullptr, nullptr}};
                      RUN_GEMM(pg8::EpiOut, e, xb, DM, xmw, DM, MTOK, 512, DM); }
                    PHASE_END
                    PHASE_BEGIN
                    { const bf16_t* XQ = (const bf16_t*)(ws + WS_XQ); const bf16_t* KM = (const bf16_t*)(ws + WS_KMEM) + (size_t)layer * MMEM * 512;
                      const bf16_t* VM = (const bf16_t*)(ws + WS_VTMEM) + (size_t)layer * 512 * MMEM;
                      for (int rep = 0; rep < REP_ATT; ++rep) for (int r = 0;; ++r) { const int u = r * G + bid; if (u >= 512) break;
                          const int qb = u >> 5, bh = u & 31, b = bh >> 2, h = bh & 3;
                          attn_unit<128, 128, 2, 1, false>(lds, XQ + (size_t)b * SEQ * 512 + h * 128, 512, KM + (size_t)b * MEMLEN * 512 + h * 128, 512,
                                                 VM + (size_t)(h * 128) * MMEM + (size_t)b * MEMLEN, MMEM, (bf16_t*)(ws + WS_XO) + (size_t)b * SEQ * 512 + h * 128, 512,
                                                 qb * 256, 4, 0.08838834764831845f * LOG2E, IN(29) + layer * 128, nullptr, 0.f, 0.f, wave_s); } }
                    PHASE_END
                    PHASE_BEGIN
                    { pg8::EpiResidB<1> e{nullptr, nullptr, xb, SSQ(nssq + 1), 1.0f};
                      RUN_GEMM(pg8::EpiResidB<1>, e, ws + WS_XO, 512, xmw + 3 * 512 * 1024, 512, MTOK, DM, 512); }
                    PHASE_END
                    ++nssq;
#undef xmw
                }
            }
            const int f = layer * 2 + half;
            PHASE_BEGIN
            { pg8::EpiSwiGLU e{(bf16_t*)(ws + WS_H), SSQ(nssq)};
              for (int rep = 0; rep < REP_G1; ++rep) RUN_GEMM(pg8::EpiSwiGLU, e, xb, DM, ws + WS_FFN + f * SZ_FFN, DM, MTOK, 2 * DFF, DM);
              if constexpr (layer == 0 && half == 0) {
                  for (int l = 0; l < 2; ++l) {
                      const bf16_t* xmw = (const bf16_t*)(ws + WS_XM + l * 4 * MiB);
                      pg8::EpiOut ek{(bf16_t*)(ws + WS_KMEM) + (size_t)l * MMEM * 512, 512, SSQ(SSQ_MEM), 1.0f / DM, 0, 0, {nullptr, nullptr, nullptr, nullptr}};
                      RUN_GEMM(pg8::EpiOut, ek, memb, DM, xmw + 512 * 1024, DM, MMEM, 512, DM);
                      pg8::EpiOutT ev{(bf16_t*)(ws + WS_VTMEM) + (size_t)l * 512 * MMEM, MMEM, SSQ(SSQ_MEM), 1.0f / DM};
                      RUN_GEMM(pg8::EpiOutT, ev, xmw + 2 * 512 * 1024, DM, memb, DM, 512, MMEM, DM);
                  }
              } }
            PHASE_END
            PHASE_BEGIN
            { constexpr int RMV = (layer == 0 && half == 0) ? 0 : ((layer == 1 && half == 1) ? 2 : 1);
              pg8::EpiResidB<RMV> e{IN(0), xout, xb, SSQ(nssq + 1), 0.5f};
              RUN_GEMM(pg8::EpiResidB<RMV>, e, ws + WS_H, DFF, ws + WS_FFN + f * SZ_FFN + SZ_WGU, DFF, MTOK, DM, DFF);
              if constexpr (layer == 0 && half == 0) {
                  for (int l = 0; l < 2; ++l) pp_norm128((bf16_t*)(ws + WS_KMEM) + (size_t)l * MMEM * 512, MMEM * 4, IN(30) + l * 128, gw, NGW, lane);
              } }
            PHASE_END
            ++nssq; xcur = xout;
    }
}

constexpr int N_PHASES = 22;
extern "C" void kernel_launch(void* const* d_in, const int* in_sizes, int n_in, void* d_out, int out_size, void* d_ws, size_t ws_size, hipStream_t stream) {
    static int grid = 0;
    if (grid == 0) {
        if (n_in != 32 || ws_size < WS_END) { fprintf(stderr, "kernel_launch: unexpected n_in %d / ws %zu\n", n_in, ws_size); grid = -1; return; }
        int dev = 0, cus = 0, per_cu = 0;
        hipGetDevice(&dev);
        hipDeviceGetAttribute(&cus, hipDeviceAttributeMultiprocessorCount, dev);
        hipFuncSetAttribute((const void*)fwd_kernel, hipFuncAttributeMaxDynamicSharedMemorySize, LDS_BYTES);
        hipOccupancyMaxActiveBlocksPerMultiprocessor(&per_cu, (const void*)fwd_kernel, 512, LDS_BYTES);
        if (per_cu < 1) per_cu = 1;
        grid = cus * per_cu;
        fprintf(stderr, "kernel_launch: cus %d per_cu %d grid %d\n", cus, per_cu, grid);
    }
    if (grid < 0) return;
    Params p{};
    for (int i = 0; i < 32; ++i) p.in[i] = (const float*)d_in[i];
    p.out = (float*)d_out; p.ws = (unsigned char*)d_ws;
    (void)hipMemsetAsync((char*)d_ws + WS_BAR, 0, BAR_BYTES, stream);
#ifdef MULTI_LAUNCH
    for (int k = 0; k < N_PHASES; ++k) { p.lo = k; p.hi = k + 1; hipLaunchKernelGGL(fwd_kernel, dim3(grid), dim3(512), LDS_BYTES, stream, p); }
#else
    p.lo = 0; p.hi = N_PHASES;
    void* args[] = {&p};
    hipError_t e = hipLaunchCooperativeKernel((const void*)fwd_kernel, dim3(grid), dim3(512), args, LDS_BYTES, stream);
    if (e != hipSuccess) fprintf(stderr, "cooperative launch failed: %s (grid %d)\n", hipGetErrorString(e), grid);
#endif
}
```
